# Optimizing an MI355X kernel written in HIP

```python
import jax, jax.numpy as jnp
from jax import lax
import numpy as np


D_MODEL = 2048
BATCH = 1
SEQ = 8192
DEPTH = 2

HEAD_DIM = 128
SB_HEADS = 6
RET_HEADS = 4
DSA_HEADS = 6
D_SB = SB_HEADS * HEAD_DIM
D_RET = RET_HEADS * HEAD_DIM
D_DSA = DSA_HEADS * HEAD_DIM
D_MIX = D_SB + D_RET + D_DSA
KV_RANK = 256
IDX_HEADS = 8
IDX_DIM = 64
IDX_SCALE = IDX_DIM ** -0.5 * IDX_HEADS ** -0.5
TOPK_MAX = 256
Q_BLOCK = 128
RET_CHUNK = 128
N_EXPERTS = 16
N_GROUPS = 4
EXPERTS_PER_GROUP = N_EXPERTS // N_GROUPS
TOP_K_EXPERTS = 2
D_FF_EXPERT = 512
LN_EPS = 1e-5
RMS_EPS = 1e-6
GN_EPS = 1e-6
DEEPNORM_ALPHA = (2 * DEPTH) ** 0.25
DEEPNORM_BETA = (8 * DEPTH) ** -0.25
SPLITS = (D_SB, D_SB, D_SB,
          D_RET, D_RET, D_RET, D_RET,
          D_DSA, KV_RANK, IDX_HEADS * IDX_DIM, IDX_DIM, IDX_HEADS)
D_IN = sum(SPLITS)

kernel_name = 'hybrid_sb_ret_dsa_grouped_moe_deepnorm'


def layer_norm(x, g, b):
    xf = x.astype(jnp.float32)
    mu = jnp.mean(xf, axis=-1, keepdims=True)
    var = jnp.mean(jnp.square(xf - mu), axis=-1, keepdims=True)
    return ((xf - mu) * lax.rsqrt(var + LN_EPS) * g + b).astype(x.dtype)


def rms_norm(x, g):
    xf = x.astype(jnp.float32)
    y = xf * lax.rsqrt(jnp.mean(jnp.square(xf), axis=-1, keepdims=True) + RMS_EPS) * g
    return y.astype(x.dtype)


def split_columns(p):
    outs, o = [], 0
    for n in SPLITS:
        outs.append(p[..., o:o + n])
        o += n
    return outs


def to_blocks(x):
    b, s = x.shape[:2]
    return jnp.moveaxis(x.reshape((b, s // Q_BLOCK, Q_BLOCK) + x.shape[2:]), 1, 0)


def from_blocks(y):
    y = jnp.moveaxis(y, 0, 1)
    return y.reshape((y.shape[0], y.shape[1] * y.shape[2]) + y.shape[3:])


def stick_breaking_attention(q, k, v):
    b, s, h, d = q.shape
    scale = d ** -0.5
    kf = k.astype(jnp.float32)
    vf = v.astype(jnp.float32)
    key_pos = jnp.arange(s)

    def block(args):
        qblk, i = args
        t = i * Q_BLOCK + jnp.arange(Q_BLOCK)
        strict = key_pos[None, :] < t[:, None]
        z = jnp.einsum('bqhd,bkhd->bhqk', qblk.astype(jnp.float32), kf) * scale
        log_rem = jnp.where(strict, jax.nn.log_sigmoid(-z), 0.0)
        after = lax.cumsum(log_rem, axis=3, reverse=True) - log_rem
        a = jnp.where(strict, jnp.exp(jax.nn.log_sigmoid(z) + after), 0.0)
        return jnp.einsum('bhqk,bkhd->bqhd', a, vf)

    nb = s // Q_BLOCK
    out = lax.map(block, (to_blocks(q), jnp.arange(nb)))
    return from_blocks(out).reshape(b, s, h * d).astype(q.dtype)


def rotary(x, pos):
    half = x.shape[-1] // 2
    theta = 10000.0 ** (-jnp.linspace(0.0, 1.0, half, dtype=jnp.float32))
    ang = pos[:, None] * theta[None, :]
    cos = jnp.cos(ang)[None, :, None, :]
    sin = jnp.sin(ang)[None, :, None, :]
    x1, x2 = x[..., :half], x[..., half:]
    return jnp.concatenate([x1 * cos - x2 * sin, x1 * sin + x2 * cos], axis=-1)


def retention(q, k, v, g, gn_g):
    b, s, h, d = q.shape
    pos = jnp.arange(s, dtype=jnp.float32)
    qf = rotary(q.astype(jnp.float32), pos)
    kf = rotary(k.astype(jnp.float32), pos) * d ** -0.5
    vf = v.astype(jnp.float32)
    log_gamma = jnp.log1p(-(2.0 ** (-5.0 - jnp.arange(h, dtype=jnp.float32))))
    c = RET_CHUNK
    nc = s // c
    idx = jnp.arange(c, dtype=jnp.float32)
    diff = idx[:, None] - idx[None, :]
    intra = jnp.where(diff >= 0, jnp.exp(jnp.maximum(diff, 0.0)[None] * log_gamma[:, None, None]), 0.0)
    q_decay = jnp.exp((idx[None, :] + 1.0) * log_gamma[:, None])
    k_decay = jnp.exp((c - 1.0 - idx[None, :]) * log_gamma[:, None])
    chunk_decay = jnp.exp(c * log_gamma)

    def chunks(x):
        return x.reshape(b, nc, c, h, d).transpose(1, 0, 3, 2, 4)

    def step(state, inp):
        qc, kc, vc = inp
        scores = jnp.einsum('bhid,bhjd->bhij', qc, kc) * intra[None]
        o = (jnp.einsum('bhij,bhje->bhie', scores, vc)
             + jnp.einsum('bhid,bhde->bhie', qc * q_decay[None, :, :, None], state))
        state = (chunk_decay[None, :, None, None] * state
                 + jnp.einsum('bhjd,bhje->bhde', kc * k_decay[None, :, :, None], vc))
        return state, o

    state0 = jnp.zeros((b, h, d, d), jnp.float32)
    _, outs = lax.scan(step, state0, (chunks(qf), chunks(kf), chunks(vf)))
    o = outs.transpose(1, 0, 3, 2, 4).reshape(b, s, h, d)
    mu = jnp.mean(o, axis=-1, keepdims=True)
    var = jnp.mean(jnp.square(o - mu), axis=-1, keepdims=True)
    o = ((o - mu) * lax.rsqrt(var + GN_EPS)).reshape(b, s, h * d) * gn_g
    return (jax.nn.silu(g.astype(jnp.float32)) * o).astype(q.dtype)


def dsa_attention(q, c_kv, q_idx, k_idx, w_idx, kv_norm_g, w_kv_up):
    b, s, h, d = q.shape
    topk = min(TOPK_MAX, s // 4)
    kv = jnp.einsum('bsr,rn->bsn', rms_norm(c_kv, kv_norm_g), w_kv_up).reshape(b, s, h, 2, d)
    k = kv[..., 0, :]
    v = kv[..., 1, :]
    k_idx_f = k_idx.astype(jnp.float32)
    key_pos = jnp.arange(s)
    gather = jax.vmap(lambda xx, ii: xx[ii])

    def block(args):
        qb, qib, wb, i = args
        t = i * Q_BLOCK + jnp.arange(Q_BLOCK)
        causal = key_pos[None, :] <= t[:, None]
        rel = jax.nn.relu(jnp.einsum('bqhd,bkd->bqhk', qib.astype(jnp.float32), k_idx_f))
        score = jnp.einsum('bqhk,bqh->bqk', rel, wb.astype(jnp.float32)) * IDX_SCALE
        score = jnp.where(causal[None], score, -jnp.inf)
        _, sel = lax.top_k(score, topk)
        valid = sel <= t[None, :, None]
        k_sel = gather(k, sel).astype(jnp.float32)
        v_sel = gather(v, sel).astype(jnp.float32)
        logits = jnp.einsum('bqhd,bqkhd->bhqk', qb.astype(jnp.float32), k_sel) * d ** -0.5
        logits = jnp.where(valid[:, None], logits, -jnp.inf)
        p = jax.nn.softmax(logits, axis=-1)
        return jnp.einsum('bhqk,bqkhd->bqhd', p, v_sel)

    nb = s // Q_BLOCK
    out = lax.map(block, (to_blocks(q), to_blocks(q_idx), to_blocks(w_idx), jnp.arange(nb)))
    return from_blocks(out).reshape(b, s, h * d).astype(q.dtype)


def grouped_moe(x, w_router, w_gate, w_up, w_down):
    logits = jnp.einsum('bsd,de->bse', x.astype(jnp.float32), w_router.astype(jnp.float32))
    probs = jax.nn.softmax(logits, axis=-1)
    grouped = probs.reshape(probs.shape[:2] + (N_GROUPS, EXPERTS_PER_GROUP))
    group_score = jnp.sum(lax.top_k(grouped, TOP_K_EXPERTS)[0], axis=-1)
    g_sel = jnp.argmax(group_score, axis=-1)
    in_group = jnp.take_along_axis(grouped, g_sel[..., None, None], axis=2)[..., 0, :]
    top_w, top_i = lax.top_k(in_group, TOP_K_EXPERTS)
    top_w = top_w / jnp.sum(top_w, axis=-1, keepdims=True)
    expert_ids = g_sel[..., None] * EXPERTS_PER_GROUP + top_i
    gates = jnp.sum(jax.nn.one_hot(expert_ids, N_EXPERTS, dtype=jnp.float32) * top_w[..., None], axis=-2)
    hg = jnp.einsum('bsd,edf->bsef', x, w_gate)
    hu = jnp.einsum('bsd,edf->bsef', x, w_up)
    act = jax.nn.silu(hg) * hu * gates[..., None].astype(x.dtype)
    return jnp.einsum('bsef,efd->bsd', act, w_down)


def setup_inputs(seed: int = 0) -> dict:
    key = jax.random.key(seed)
    ks = jax.random.split(key, 16)
    f32 = jnp.float32
    nrm = lambda k, shp, sc: jax.random.normal(k, shp, f32) * sc
    return {
        'x': nrm(ks[0], (BATCH, SEQ, D_MODEL), 1.0),
        'w_in': nrm(ks[1], (DEPTH, D_MODEL, D_IN), D_MODEL ** -0.5),
        'w_kv_up': nrm(ks[2], (DEPTH, KV_RANK, DSA_HEADS * 2 * HEAD_DIM), KV_RANK ** -0.5),
        'kv_norm_g': 1.0 + nrm(ks[3], (DEPTH, KV_RANK), 0.02),
        'ret_gn_g': 1.0 + nrm(ks[4], (DEPTH, D_RET), 0.02),
        'w_o': nrm(ks[5], (DEPTH, D_MIX, D_MODEL), D_MIX ** -0.5 * DEEPNORM_BETA),
        'ln1_g': 1.0 + nrm(ks[6], (DEPTH, D_MODEL), 0.02),
        'ln1_b': nrm(ks[7], (DEPTH, D_MODEL), 0.02),
        'w_router': nrm(ks[8], (D_MODEL, N_EXPERTS), D_MODEL ** -0.5),
        'w_gate': nrm(ks[9], (DEPTH, N_EXPERTS, D_MODEL, D_FF_EXPERT), D_MODEL ** -0.5),
        'w_up': nrm(ks[10], (DEPTH, N_EXPERTS, D_MODEL, D_FF_EXPERT), D_MODEL ** -0.5),
        'w_down': nrm(ks[11], (DEPTH, N_EXPERTS, D_FF_EXPERT, D_MODEL), D_FF_EXPERT ** -0.5 * DEEPNORM_BETA),
        'ln2_g': 1.0 + nrm(ks[12], (DEPTH, D_MODEL), 0.02),
        'ln2_b': nrm(ks[13], (DEPTH, D_MODEL), 0.02),
    }


def reference(x, w_in, w_kv_up, kv_norm_g, ret_gn_g, w_o, ln1_g, ln1_b, w_router,
              w_gate, w_up, w_down, ln2_g, ln2_b):
    b, s, _ = x.shape
    for l in range(DEPTH):
        proj = jnp.einsum('bsd,dn->bsn', x, w_in[l])
        (sb_q, sb_k, sb_v, r_q, r_k, r_v, r_g,
         d_q, d_ckv, d_qi, d_ki, d_w) = split_columns(proj)
        heads = lambda t, n: t.reshape(b, s, n, HEAD_DIM)
        y_sb = stick_breaking_attention(heads(sb_q, SB_HEADS), heads(sb_k, SB_HEADS), heads(sb_v, SB_HEADS))
        y_ret = retention(heads(r_q, RET_HEADS), heads(r_k, RET_HEADS), heads(r_v, RET_HEADS), r_g, ret_gn_g[l])
        y_dsa = dsa_attention(heads(d_q, DSA_HEADS), d_ckv, d_qi.reshape(b, s, IDX_HEADS, IDX_DIM),
                              d_ki, d_w, kv_norm_g[l], w_kv_up[l])
        mix = jnp.einsum('bsm,md->bsd', jnp.concatenate([y_sb, y_ret, y_dsa], axis=-1), w_o[l])
        x = layer_norm(DEEPNORM_ALPHA * x + mix, ln1_g[l], ln1_b[l])
        ffn = grouped_moe(x, w_router, w_gate[l], w_up[l], w_down[l])
        x = layer_norm(DEEPNORM_ALPHA * x + ffn, ln2_g[l], ln2_b[l])
    return x
```

```cpp
#include <hip/hip_runtime.h>
#include <stdint.h>
#include <stdio.h>

#define LAS __attribute__((address_space(3)))
typedef unsigned short bf16_t;
typedef short bf16x8 __attribute__((ext_vector_type(8)));
typedef short bf16x4 __attribute__((ext_vector_type(4)));
typedef float f32x2 __attribute__((ext_vector_type(2)));
typedef float f32x4 __attribute__((ext_vector_type(4)));
typedef float f32x16 __attribute__((ext_vector_type(16)));
typedef unsigned u32x2 __attribute__((ext_vector_type(2)));
typedef unsigned u32x4 __attribute__((ext_vector_type(4)));

constexpr int SEQ = 8192, DM = 2048, DIN = 5960, NTHR = 512;
constexpr float ALPHA = 1.41421356237309515f;
constexpr float LOG2E = 1.44269504088896341f;
constexpr float SB_QSCALE = 0.08838834764831845f * LOG2E;
constexpr float IDX_SCALE = 0.04419417382415922f;
constexpr int LDS_BYTES = 147456;

constexpr size_t WS_CTL = 0, CTL_BYTES = 65536;
constexpr size_t Z_BYTES = (size_t)(8192 + 6144) * 2048 * 2;
constexpr size_t WS_Z = WS_CTL + CTL_BYTES;
constexpr size_t WS_ROT = WS_Z + Z_BYTES;
constexpr size_t WS_WOT = WS_ROT + (size_t)8192 * 64 * 8;
constexpr size_t WS_WGU = WS_WOT + (size_t)2048 * 2048 * 2;
constexpr size_t WS_WDT = WS_WGU + (size_t)16 * 1024 * 2048 * 2;
constexpr size_t WS_WABS = WS_WDT + (size_t)16 * 2048 * 512 * 2;
constexpr size_t WS_WUVP = WS_WABS + (size_t)3 * 512 * 256 * 2;
constexpr size_t WS_EID = WS_WUVP + (size_t)3 * 256 * 512 * 2;
constexpr size_t WS_GW = WS_EID + (size_t)SEQ * 2 * 4;
constexpr size_t WS_SLOT = WS_GW + (size_t)SEQ * 2 * 4;
constexpr int XS_ROWS = 20480;
constexpr size_t WS_SGW = WS_SLOT + (size_t)SEQ * 2 * 4;
constexpr size_t WS_YCAT = WS_SGW + (size_t)XS_ROWS * 4;
constexpr size_t WS_R = WS_YCAT + (size_t)SEQ * 2048 * 2;
constexpr size_t WS_QSB = WS_R;
constexpr size_t WS_KSB = WS_QSB + (size_t)SEQ * 768 * 2;
constexpr size_t WS_VT = WS_KSB + (size_t)SEQ * 768 * 2;
constexpr size_t WS_QR = WS_VT + (size_t)SEQ * 768 * 2;
constexpr size_t WS_KR = WS_QR + (size_t)SEQ * 512 * 2;
constexpr size_t WS_VR = WS_KR + (size_t)SEQ * 512 * 2;
constexpr size_t WS_GR = WS_VR + (size_t)SEQ * 512 * 2;
constexpr size_t WS_QD = WS_GR + (size_t)SEQ * 512 * 2;
constexpr size_t WS_CKV = WS_QD + (size_t)SEQ * 768 * 2;
constexpr size_t WS_QI = WS_CKV + (size_t)SEQ * 256 * 2;
constexpr size_t WS_KW = WS_QI + (size_t)SEQ * 512 * 2;
constexpr size_t WS_CN = WS_KW + (size_t)SEQ * 256 * 2;
constexpr size_t WS_QP = WS_CN + (size_t)SEQ * 256 * 2;
constexpr size_t WS_KVT = WS_QP + (size_t)SEQ * 1536 * 2;
constexpr size_t WS_ST = WS_KVT + (size_t)4 * 64 * 128 * 128 * 4;
constexpr size_t WS_OP = WS_ST + (size_t)4 * 64 * 128 * 128 * 2;
constexpr size_t WS_SC = WS_OP + (size_t)SEQ * 1536 * 2;
constexpr size_t SC_ELEMS = (size_t)16 * 2048 * 2049 / 2;
constexpr size_t WS_END_ATT = WS_SC + SC_ELEMS * 4;
constexpr size_t WS_X1 = WS_R;
constexpr size_t WS_XS = WS_X1 + (size_t)SEQ * 2048 * 4;
constexpr size_t WS_ACT = WS_XS + (size_t)XS_ROWS * 2048 * 2;
constexpr size_t WS_DN = WS_ACT + (size_t)XS_ROWS * 512 * 2;
constexpr size_t WS_END_FFN = WS_DN + (size_t)XS_ROWS * 2048 * 2;
constexpr size_t WS_END = WS_END_ATT > WS_END_FFN ? WS_END_ATT : WS_END_FFN;
static_assert(WS_END <= (size_t)604313600, "workspace over the guaranteed minimum");
__host__ __device__ __forceinline__ size_t sc_rowoff(int t) { const size_t a = (size_t)(t >> 2), b = (size_t)(t & 3); return 4 * (a + 1) * (2 * a + b); }
constexpr int CW_BAR = 0;
constexpr int CW_NT = 4096;
constexpr int CW_TEXP = 4160;
constexpr int CW_BCNT = 4352;
constexpr int CW_SLOT = 8448;

struct Params {
    const float* x; const float* w_in; const float* w_kv_up; const float* kv_norm_g; const float* ret_gn_g;
    const float* w_o; const float* ln1_g; const float* ln1_b; const float* w_router;
    const float* w_gate; const float* w_up; const float* w_down; const float* ln2_g; const float* ln2_b;
    float* out; unsigned char* ws; int ph_lo, ph_hi;
};

__device__ __forceinline__ unsigned cvt_pk_bf16(float lo, float hi) { unsigned r; asm("v_cvt_pk_bf16_f32 %0, %1, %2" : "=v"(r) : "v"(lo), "v"(hi)); return r; }
__device__ __forceinline__ float bflo(unsigned u) { return __uint_as_float(u << 16); }
__device__ __forceinline__ float bfhi(unsigned u) { return __uint_as_float(u & 0xffff0000u); }
__device__ __forceinline__ float wave_sum(float v) {
#pragma unroll
    for (int m = 32; m >= 1; m >>= 1) v += __shfl_xor(v, m);
    return v;
}
__device__ __forceinline__ f32x16 mfma32(bf16x8 a, bf16x8 b, f32x16 c) { return __builtin_amdgcn_mfma_f32_32x32x16_bf16(a, b, c, 0, 0, 0); }
__device__ __forceinline__ f32x4 mfma16(bf16x8 a, bf16x8 b, f32x4 c) { return __builtin_amdgcn_mfma_f32_16x16x32_bf16(a, b, c, 0, 0, 0); }
__device__ __forceinline__ bf16x8 as_bf16x8(u32x4 v) { return __builtin_bit_cast(bf16x8, v); }

#define XB_TMO      128
#define XB_XCNT(j)  (256  + 64 * (j))
#define XB_XSUB(j)  (1280 + 64 * (j))
#define XB_XGEN(j)  (2304 + 64 * (j))
#define XB_TOP      3328
#define XB_TOPGEN   3392
#define XCD_BAR_WORDS 3456
#define XB_SPIN_CAP (1u << 22)
__device__ __forceinline__ unsigned xb_ld(unsigned* p)              { return __hip_atomic_load(p, __ATOMIC_RELAXED, __HIP_MEMORY_SCOPE_AGENT); }
__device__ __forceinline__ unsigned xb_add(unsigned* p, unsigned v) { return __hip_atomic_fetch_add(p, v, __ATOMIC_RELAXED, __HIP_MEMORY_SCOPE_AGENT); }
__device__ __forceinline__ unsigned xb_xcc_id() { return (unsigned)__builtin_amdgcn_s_getreg((3 << 11) | 20) & 0xFu; }
#define XB_SPIN(cond, bar) do { unsigned _sp = 0; while (cond) { __builtin_amdgcn_s_sleep(1); \
    if ((++_sp & 255u) == 0u) { if (xb_ld(&(bar)[XB_TMO])) break; if (_sp > XB_SPIN_CAP) { atomicAdd(&(bar)[XB_TMO], 1u); break; } } } } while (0)
struct XcdBarrier { unsigned* bar; unsigned x; volatile LAS unsigned* st; };
__device__ __forceinline__ XcdBarrier xcd_barrier_post(unsigned* bar, volatile LAS unsigned* st) {
    XcdBarrier b; b.bar = bar; b.x = xb_xcc_id(); b.st = st;
    if (threadIdx.x == 0) (void)xb_add(&bar[XB_XCNT(b.x)], 1u);
    return b;
}
__device__ __forceinline__ void xcd_barrier_complete(unsigned* bar, unsigned x, unsigned& nloc, unsigned& nx) {
    const unsigned G = gridDim.x * gridDim.y * gridDim.z;
    unsigned sum, cnt, mine, sp = 0u;
    for (;;) {
        sum = 0u; cnt = 0u; mine = 0u;
#pragma unroll
        for (unsigned j = 0; j < 16; ++j) { const unsigned c = xb_ld(&bar[XB_XCNT(j)]); sum += c; cnt += (c > 0u) ? 1u : 0u; mine = (j == x) ? c : mine; }
        if (sum == G) break;
        __builtin_amdgcn_s_sleep(1);
        if ((++sp & 255u) == 0u) { if (xb_ld(&bar[XB_TMO])) break; if (sp > XB_SPIN_CAP) { atomicAdd(&bar[XB_TMO], 1u); break; } }
    }
    nloc = mine > 0u ? mine : 1u; nx = cnt > 0u ? cnt : 1u;
}
__device__ __forceinline__ void xcd_barrier(const XcdBarrier& b) {
    asm volatile("s_waitcnt vmcnt(0)" ::: "memory");
    __syncthreads();
    if (threadIdx.x == 0) {
        unsigned* bar = b.bar;
        __builtin_amdgcn_s_waitcnt(0);
        unsigned nloc = b.st[0], nx = b.st[1];
        if (nloc == 0u) { xcd_barrier_complete(bar, b.x, nloc, nx); b.st[0] = nloc; b.st[1] = nx; }
        const unsigned old = xb_add(&bar[XB_XSUB(b.x)], 1u);
        const unsigned gen = old / nloc;
        if (old + 1u == (gen + 1u) * nloc) {
            __builtin_amdgcn_fence(__ATOMIC_RELEASE, "agent");
            asm volatile("s_waitcnt vmcnt(0)" ::: "memory");
            const unsigned og = xb_add(&bar[XB_TOP], 1u);
            const unsigned tg = og / nx;
            if (og + 1u == (tg + 1u) * nx) xb_add(&bar[XB_TOPGEN], 1u);
            else XB_SPIN(xb_ld(&bar[XB_TOPGEN]) == tg, bar);
            __builtin_amdgcn_fence(__ATOMIC_ACQUIRE, "agent");
            xb_add(&bar[XB_XGEN(b.x)], 1u);
            asm volatile("s_waitcnt vmcnt(0)" ::: "memory");
        } else {
            XB_SPIN(xb_ld(&bar[XB_XGEN(b.x)]) == gen, bar);
            __builtin_amdgcn_fence(__ATOMIC_ACQUIRE, "agent");
            asm volatile("s_waitcnt vmcnt(0)" ::: "memory");
        }
    }
    __syncthreads();
}

namespace pg8 {
constexpr int BM = 256, BK = 64, HALF = 128, HTB = HALF * BK * 2, STAGE_BYTES = 8 * HTB;
__device__ __forceinline__ void stage_rc(int b, int& R, int& C) { const int st = b / 1024, sb = b % 1024, swz = sb ^ (((sb >> 9) & 1) << 5); R = (st >> 1) * 16 + swz / 64; C = (st & 1) * 32 + (swz % 64) / 2; }
__device__ __forceinline__ int lds_byte(int r, int c) { const int st = (r >> 4) * 2 + (c >> 5), rr = r & 15, cc = c & 31, ob = rr * 64 + cc * 2; return st * 1024 + (ob ^ (((ob >> 9) & 1) << 5)); }
__device__ __forceinline__ int perm32(int rho) { const int n = rho >> 4, i = rho & 15; return 8 * (i >> 2) + 4 * n + (i & 3); }
struct Unit { int pm, pn, kind; const char* pa; const char* pb; };
struct Dims { int K, lda, ldb; };

template <class Epi, class Sched>
__device__ __forceinline__ void gemm_phase(LAS unsigned char* lds, const Dims g, const Sched& S, const Epi& E, const int tid) {
    const int wid = __builtin_amdgcn_readfirstlane(tid >> 6), lane = tid & 63, wr = wid >> 2, wc = wid & 3, fr = lane & 15, fq = lane >> 4;
    const int K = g.K, nt = K / BK;
    unsigned voffA[2], voffB[2];
#pragma unroll
    for (int i = 0; i < 2; ++i) { int R, C; stage_rc(tid * 16 + i * 8192, R, C); const int Rb = (R & ~31) + perm32(R & 31);
        voffA[i] = (unsigned)(R * g.lda + C) * 2u; voffB[i] = (unsigned)(Rb * g.ldb + C) * 2u; }
    const size_t kstep = (size_t)(BK * 2);
    const size_t hstepA = (size_t)HALF * g.lda * 2, hstepB = (size_t)HALF * g.ldb * 2;
    const unsigned ldsw = (unsigned)wid * 1024u;
    const int aoff = lds_byte(wr * 64 + fr, fq * 8), boff = lds_byte(wc * 32 + fr, fq * 8);
#define PG8_SA(b, h) (((b) * 2 + (h)) * HTB)
#define PG8_SB(b, h) ((4 + (b) * 2 + (h)) * HTB)
#define PG8_STAGE(bufoff, gbase, voff) do { _Pragma("unroll") for (int _i = 0; _i < 2; ++_i) \
        __builtin_amdgcn_global_load_lds((const unsigned*)((const char*)(gbase) + (voff)[_i]), (LAS unsigned*)(lds + (bufoff) + ldsw + _i * 8192), 16, 0, 0); } while (0)
#define PG8_LDA(dst, b, h) do { _Pragma("unroll") for (int m = 0; m < 4; ++m) _Pragma("unroll") for (int k = 0; k < 2; ++k) dst[m][k] = *(const LAS bf16x8*)(lds + PG8_SA(b, h) + aoff + m * 2048 + k * 1024); } while (0)
#define PG8_LDB(dst, b, h) do { _Pragma("unroll") for (int n = 0; n < 2; ++n) _Pragma("unroll") for (int k = 0; k < 2; ++k) dst[n][k] = *(const LAS bf16x8*)(lds + PG8_SB(b, h) + boff + n * 2048 + k * 1024); } while (0)
#define PG8_MMA(ai, bj, At, Bt) do { __builtin_amdgcn_s_setprio(1); _Pragma("unroll") for (int m = 0; m < 4; ++m) _Pragma("unroll") for (int n = 0; n < 2; ++n) _Pragma("unroll") for (int k = 0; k < 2; ++k) \
        acc[ai][bj][m][n] = __builtin_amdgcn_mfma_f32_16x16x32_bf16(Bt[n][k], At[m][k], acc[ai][bj][m][n], 0, 0, 0); __builtin_amdgcn_s_setprio(0); } while (0)
#define PG8_WAIT_V(n) asm volatile("s_waitcnt vmcnt(" #n ")" ::: "memory")
#define PG8_WAIT_L(n) asm volatile("s_waitcnt lgkmcnt(" #n ")" ::: "memory")
#define PG8_BAR __builtin_amdgcn_s_barrier()
#define PG8_SCHED __builtin_amdgcn_sched_barrier(0)
    Unit cur, nxt; int ui = 0;
    if (!S.next(0, cur)) return;
    f32x4 acc[2][2][4][2];
#pragma unroll
    for (int a = 0; a < 2; ++a)
#pragma unroll
        for (int b = 0; b < 2; ++b)
#pragma unroll
            for (int m = 0; m < 4; ++m)
#pragma unroll
                for (int n = 0; n < 2; ++n) acc[a][b][m][n] = (f32x4){0.f, 0.f, 0.f, 0.f};
    bf16x8 At[4][2], B0[2][2], B1[2][2];
    const char* cA = cur.pa; const char* cB = cur.pb;
    PG8_STAGE(PG8_SB(0, 0), cB, voffB); PG8_STAGE(PG8_SA(0, 0), cA, voffA); PG8_STAGE(PG8_SB(0, 1), cB + hstepB, voffB); PG8_STAGE(PG8_SA(0, 1), cA + hstepA, voffA);
    if (wr == 1) PG8_BAR;
    PG8_WAIT_V(4); PG8_BAR;
    PG8_STAGE(PG8_SB(1, 0), cB + kstep, voffB); PG8_STAGE(PG8_SA(1, 0), cA + kstep, voffA); PG8_STAGE(PG8_SB(1, 1), cB + hstepB + kstep, voffB);
    PG8_WAIT_V(6); PG8_BAR;
    for (;;) {
        const bool has_next = S.next(ui + 1, nxt);
        const char* nA = has_next ? nxt.pa : cA; const char* nB = has_next ? nxt.pb : cB;
        for (int t = 0; t < nt; t += 2) {
            const bool last = (t == nt - 2);
            const char* a1 = cA + (size_t)(t + 1) * kstep;
            const char* a2 = last ? nA : cA + (size_t)(t + 2) * kstep; const char* b2 = last ? nB : cB + (size_t)(t + 2) * kstep;
            const char* a3 = a2 + kstep; const char* b3 = b2 + kstep;
            PG8_LDB(B0, 0, 0); PG8_SCHED; PG8_LDA(At, 0, 0); PG8_STAGE(PG8_SA(1, 1), a1 + hstepA, voffA);
            PG8_WAIT_L(8); PG8_BAR; PG8_WAIT_L(0); PG8_MMA(0, 0, At, B0); PG8_BAR; PG8_SCHED;
            PG8_LDB(B1, 0, 1); PG8_STAGE(PG8_SB(0, 0), b2, voffB);
            PG8_BAR; PG8_WAIT_L(0); PG8_MMA(0, 1, At, B1); PG8_BAR;
            PG8_LDA(At, 0, 1); PG8_STAGE(PG8_SA(0, 0), a2, voffA);
            PG8_BAR; PG8_WAIT_L(0); PG8_MMA(1, 0, At, B0); PG8_BAR; PG8_SCHED;
            PG8_STAGE(PG8_SB(0, 1), b2 + hstepB, voffB);
            PG8_WAIT_V(6); PG8_BAR; PG8_MMA(1, 1, At, B1); PG8_BAR;
            PG8_LDB(B0, 1, 0); PG8_SCHED; PG8_LDA(At, 1, 0); PG8_STAGE(PG8_SA(0, 1), a2 + hstepA, voffA);
            PG8_WAIT_L(8); PG8_BAR; PG8_WAIT_L(0); PG8_MMA(0, 0, At, B0); PG8_BAR; PG8_SCHED;
            PG8_LDB(B1, 1, 1); PG8_STAGE(PG8_SB(1, 0), b3, voffB);
            PG8_BAR; PG8_WAIT_L(0); PG8_MMA(0, 1, At, B1); PG8_BAR;
            PG8_LDA(At, 1, 1); PG8_STAGE(PG8_SA(1, 0), a3, voffA);
            PG8_BAR; PG8_WAIT_L(0); PG8_MMA(1, 0, At, B0); PG8_BAR; PG8_SCHED;
            PG8_STAGE(PG8_SB(1, 1), b3 + hstepB, voffB);
            PG8_WAIT_V(6); PG8_BAR; PG8_MMA(1, 1, At, B1); PG8_BAR;
        }
        E(acc, cur, wr, wc, fr, fq);
        if (!has_next) break;
#pragma unroll
        for (int a = 0; a < 2; ++a)
#pragma unroll
            for (int b = 0; b < 2; ++b)
#pragma unroll
                for (int m = 0; m < 4; ++m)
#pragma unroll
                    for (int n = 0; n < 2; ++n) acc[a][b][m][n] = (f32x4){0.f, 0.f, 0.f, 0.f};
        cur = nxt; cA = nA; cB = nB; ++ui;
    }
    PG8_WAIT_V(0);
    if (wr == 0) PG8_BAR;
    PG8_BAR;
#undef PG8_SA
#undef PG8_SB
#undef PG8_STAGE
#undef PG8_LDA
#undef PG8_LDB
#undef PG8_MMA
#undef PG8_WAIT_V
#undef PG8_WAIT_L
#undef PG8_BAR
#undef PG8_SCHED
}
typedef f32x4 Acc[2][2][4][2];
__device__ __forceinline__ void store_bf16_tile(const Acc& acc, bf16_t* base, int ldc, float scale, int wr, int wc, int fr, int fq) {
#pragma unroll
    for (int ai = 0; ai < 2; ++ai)
#pragma unroll
        for (int m = 0; m < 4; ++m) {
            bf16_t* rowp = base + (size_t)(ai * HALF + wr * 64 + m * 16 + fr) * ldc + wc * 32 + 8 * fq;
#pragma unroll
            for (int bj = 0; bj < 2; ++bj) {
                const f32x4 v0 = acc[ai][bj][m][0] * scale, v1 = acc[ai][bj][m][1] * scale;
                u32x4 w; w.x = cvt_pk_bf16(v0[0], v0[1]); w.y = cvt_pk_bf16(v0[2], v0[3]); w.z = cvt_pk_bf16(v1[0], v1[1]); w.w = cvt_pk_bf16(v1[2], v1[3]);
                *(u32x4*)(rowp + bj * HALF) = w;
            }
        }
}
}

constexpr size_t TS2048 = (size_t)256 * 2048 * 2;
struct ProjSched {
    const char* Z; int G, c;
    __device__ bool next(int i, pg8::Unit& u) const {
        const int L = i * G + c; if (L >= 768) return false;
        if (L < 672) { u.pm = L / 21; u.pn = L % 21; u.kind = 0; u.pa = Z + (size_t)u.pm * TS2048; u.pb = Z + (size_t)(32 + u.pn) * TS2048; }
        else { const int L2 = L - 672; u.pm = 21 + L2 / 32; u.pn = L2 % 32; u.kind = 1; u.pa = Z + (size_t)(32 + u.pm) * TS2048; u.pb = Z + (size_t)u.pn * TS2048; }
        return true;
    }
};
struct ProjEpi {
    unsigned char* ws;
    __device__ __forceinline__ void operator()(const pg8::Acc& acc, const pg8::Unit& u, int wr, int wc, int fr, int fq) const {
        if (u.kind == 0) {
            const int j = u.pn; const size_t r0 = (size_t)u.pm * 256;
            {
                size_t off; int ld, ct; float sc = 1.0f;
                if (j < 3)       { off = WS_QSB; ld = 768; ct = j; sc = SB_QSCALE; }
                else if (j < 6)  { off = WS_KSB; ld = 768; ct = j - 3; }
                else if (j < 8)  { off = WS_QR; ld = 512; ct = j - 6; }
                else if (j < 10) { off = WS_KR; ld = 512; ct = j - 8; }
                else if (j < 12) { off = WS_VR; ld = 512; ct = j - 10; }
                else if (j < 14) { off = WS_GR; ld = 512; ct = j - 12; }
                else if (j < 17) { off = WS_QD; ld = 768; ct = j - 14; }
                else if (j < 18) { off = WS_CKV; ld = 256; ct = 0; }
                else if (j < 20) { off = WS_QI; ld = 512; ct = j - 18; }
                else             { off = WS_KW; ld = 256; ct = 0; }
                pg8::store_bf16_tile(acc, (bf16_t*)(ws + off) + r0 * ld + ct * 256, ld, sc, wr, wc, fr, fq);
            }
        } else {
            bf16_t* base = (bf16_t*)(ws + WS_VT) + (size_t)(u.pm - 21) * 256 * SEQ + (size_t)u.pn * 256;
#pragma unroll
            for (int ai = 0; ai < 2; ++ai)
#pragma unroll
                for (int m = 0; m < 4; ++m) { bf16_t* rowp = base + (size_t)(ai * 128 + wr * 64 + m * 16 + fr) * SEQ + wc * 32 + 16 * (fq >> 1) + 4 * (fq & 1);
#pragma unroll
                    for (int bj = 0; bj < 2; ++bj) { const f32x4 v0 = acc[ai][bj][m][0], v1 = acc[ai][bj][m][1];
                        u32x2 w0, w1; w0.x = cvt_pk_bf16(v0[0], v0[1]); w0.y = cvt_pk_bf16(v0[2], v0[3]); w1.x = cvt_pk_bf16(v1[0], v1[1]); w1.y = cvt_pk_bf16(v1[2], v1[3]);
                        *(u32x2*)(rowp + bj * 128) = w0; *(u32x2*)(rowp + bj * 128 + 8) = w1; } }
        }
    }
};
struct GridSched {
    const char* A; const char* B; int nM, nN, nP; size_t aTile, bTile, aBatch, bBatch; int G, c;
    __device__ bool next(int i, pg8::Unit& u) const {
        const int L = i * G + c; if (L >= nM * nN * nP) return false;
        const int p = L / (nM * nN), r = L % (nM * nN); u.pm = r / nN; u.pn = r % nN; u.kind = p;
        u.pa = A + (size_t)p * aBatch + (size_t)u.pm * aTile; u.pb = B + (size_t)p * bBatch + (size_t)u.pn * bTile; return true;
    }
};
struct Bf16Epi {
    bf16_t* O; int ldc, batchCols; float scale;
    __device__ __forceinline__ void operator()(const pg8::Acc& acc, const pg8::Unit& u, int wr, int wc, int fr, int fq) const {
        pg8::store_bf16_tile(acc, O + (size_t)u.pm * 256 * ldc + u.kind * batchCols + u.pn * 256, ldc, scale, wr, wc, fr, fq);
    }
};
struct ResF32Epi {
    float* H; const float* res;
    __device__ __forceinline__ void operator()(const pg8::Acc& acc, const pg8::Unit& u, int wr, int wc, int fr, int fq) const {
#pragma unroll
        for (int ai = 0; ai < 2; ++ai)
#pragma unroll
            for (int m = 0; m < 4; ++m) { const size_t o = (size_t)(u.pm * 256 + ai * 128 + wr * 64 + m * 16 + fr) * 2048 + u.pn * 256 + wc * 32 + 8 * fq;
#pragma unroll
                for (int bj = 0; bj < 2; ++bj) {
                    const f32x4 r0 = *(const f32x4*)(res + o + bj * 128), r1 = *(const f32x4*)(res + o + bj * 128 + 4);
                    *(f32x4*)(H + o + bj * 128) = r0 * ALPHA + acc[ai][bj][m][0]; *(f32x4*)(H + o + bj * 128 + 4) = r1 * ALPHA + acc[ai][bj][m][1]; } }
    }
};
struct MoeSched {
    const char* A; const char* B; const unsigned* ctl; int nN; size_t aTile, bTile; int G, c;
    __device__ bool next(int i, pg8::Unit& u) const {
        const int nt = (int)__hip_atomic_load(ctl + CW_NT, __ATOMIC_RELAXED, __HIP_MEMORY_SCOPE_AGENT); const int L = i * G + c; if (L >= nt * nN) return false;
        u.pm = L / nN; u.pn = L % nN; u.kind = (int)__hip_atomic_load(ctl + CW_TEXP + u.pm, __ATOMIC_RELAXED, __HIP_MEMORY_SCOPE_AGENT);
        u.pa = A + (size_t)u.pm * aTile; u.pb = B + (size_t)(u.kind * nN + u.pn) * bTile; return true;
    }
};
struct GateUpEpi {
    bf16_t* act; const float* sgw;
    __device__ __forceinline__ void operator()(const pg8::Acc& acc, const pg8::Unit& u, int wr, int wc, int fr, int fq) const {
#pragma unroll
        for (int ai = 0; ai < 2; ++ai)
#pragma unroll
            for (int m = 0; m < 4; ++m) { const int slot = u.pm * 256 + ai * 128 + wr * 64 + m * 16 + fr; const float gw = sgw[slot];
                float o[8];
#pragma unroll
                for (int n = 0; n < 2; ++n)
#pragma unroll
                    for (int e = 0; e < 4; ++e) { const float gt = acc[ai][0][m][n][e], up = acc[ai][1][m][n][e];
                        o[n * 4 + e] = gt / (1.0f + __expf(-gt)) * up * gw; }
                u32x4 w; w.x = cvt_pk_bf16(o[0], o[1]); w.y = cvt_pk_bf16(o[2], o[3]); w.z = cvt_pk_bf16(o[4], o[5]); w.w = cvt_pk_bf16(o[6], o[7]);
                *(u32x4*)(act + (size_t)slot * 512 + u.pn * 128 + wc * 32 + 8 * fq) = w; }
    }
};
struct DownEpi {
    bf16_t* dn;
    __device__ __forceinline__ void operator()(const pg8::Acc& acc, const pg8::Unit& u, int wr, int wc, int fr, int fq) const {
        pg8::store_bf16_tile(acc, dn + (size_t)u.pm * 256 * 2048 + u.pn * 256, 2048, 1.0f, wr, wc, fr, fq);
    }
};

__device__ __forceinline__ void cvt_T(LAS float* tile, const float* src, int ldsrc, int col0, int ncols, int K, bf16_t* dst, int& tbase, int bid, int nb, int tid) {
    const int ntk = K >> 6, ntn = (ncols + 63) >> 6, count = ntk * ntn;
    int g = tbase + (((bid - tbase) % nb) + nb) % nb;
    const int gend = tbase + count; tbase = gend;
    float v[8];
    if (g < gend) { const int t = g - (gend - count), tn = t / ntk, tk = t % ntk;
#pragma unroll
        for (int i = 0; i < 8; ++i) { const int idx = tid + NTHR * i, kk = idx >> 6, n = tn * 64 + (idx & 63);
            v[i] = (n < ncols) ? src[(size_t)(tk * 64 + kk) * ldsrc + col0 + n] : 0.f; } }
    for (; g < gend; g += nb) {
        const int t = g - (gend - count), tn = t / ntk, tk = t % ntk;
#pragma unroll
        for (int i = 0; i < 8; ++i) { const int idx = tid + NTHR * i; tile[(idx >> 6) * 65 + (idx & 63)] = v[i]; }
        __syncthreads();
        if (g + nb < gend) { const int t2 = g + nb - (gend - count), tn2 = t2 / ntk, tk2 = t2 % ntk;
#pragma unroll
            for (int i = 0; i < 8; ++i) { const int idx = tid + NTHR * i, kk = idx >> 6, n = tn2 * 64 + (idx & 63);
                v[i] = (n < ncols) ? src[(size_t)(tk2 * 64 + kk) * ldsrc + col0 + n] : 0.f; } }
#pragma unroll
        for (int i = 0; i < 4; ++i) { const int p = tid + NTHR * i, nn = p >> 5, kp = p & 31, n = tn * 64 + nn;
            if (n < ncols) *(unsigned*)(dst + (size_t)n * K + tk * 64 + 2 * kp) = cvt_pk_bf16(tile[(2 * kp) * 65 + nn], tile[(2 * kp + 1) * 65 + nn]); }
        __syncthreads();
    }
}
__device__ __forceinline__ void p0_common(const Params& P, unsigned char* ws, int bid, int nb, int tid) {
    const int gtid = bid * NTHR + tid, gn = nb * NTHR;
    { bf16_t* xb = (bf16_t*)(ws + WS_Z);
      for (size_t i = gtid; i < (size_t)SEQ * DM / 8; i += gn) { const f32x4 a = *(const f32x4*)(P.x + i * 8), b = *(const f32x4*)(P.x + i * 8 + 4);
          u32x4 w; w.x = cvt_pk_bf16(a[0], a[1]); w.y = cvt_pk_bf16(a[2], a[3]); w.z = cvt_pk_bf16(b[0], b[1]); w.w = cvt_pk_bf16(b[2], b[3]); *(u32x4*)(xb + i * 8) = w; } }
    { f32x2* rot = (f32x2*)(ws + WS_ROT);
      for (int i = gtid; i < SEQ * 64; i += gn) { const int t = i >> 6, f = i & 63;
          const float theta = exp2f(-((float)f / 63.0f) * 13.287712379549449f); const float ang = (float)t * theta;
          double r = (double)ang * 0.15915494309189535; r -= floor(r); const float rf = (float)r;
          rot[i] = (f32x2){__builtin_amdgcn_cosf(rf), __builtin_amdgcn_sinf(rf)}; } }
}
__device__ __forceinline__ void p0_weights(const Params& P, unsigned char* ws, LAS unsigned char* lds, int l, int bid, int nb, int tid) {
    LAS float* tile = (LAS float*)lds;
    const int gtid = bid * NTHR + tid, gn = nb * NTHR;
    {
        const float* wkv = P.w_kv_up + (size_t)l * 256 * 1536;
        bf16_t* wabs = (bf16_t*)(ws + WS_WABS); bf16_t* wuvp = (bf16_t*)(ws + WS_WUVP);
        for (int i = gtid; i < 3 * 512 * 256; i += gn) { const int k = i & 255, row = (i >> 8) & 511, p = i >> 17, hh = row >> 8, r = row & 255;
            const float v = ((k >> 7) == hh) ? wkv[(size_t)r * 1536 + (2 * p + hh) * 256 + (k & 127)] : 0.f; wabs[i] = (bf16_t)(cvt_pk_bf16(v, 0.f) & 0xffffu); }
        for (int i = gtid; i < 3 * 256 * 512; i += gn) { const int k = i & 511, row = (i >> 9) & 255, p = i >> 17, hh = row >> 7, e = row & 127;
            const float v = ((k >> 8) == hh) ? wkv[(size_t)(k & 255) * 1536 + (2 * p + hh) * 256 + 128 + e] : 0.f; wuvp[i] = (bf16_t)(cvt_pk_bf16(v, 0.f) & 0xffffu); }
        { bf16_t* wt = (bf16_t*)(ws + WS_Z) + (size_t)8192 * 2048;
          for (int i = gtid; i < 184 * 2048 / 8; i += gn) *(u32x4*)(wt + (size_t)5192 * 2048 + (size_t)i * 8) = (u32x4){0u, 0u, 0u, 0u}; }
    }
    int tb = 0;
    {
        bf16_t* wt = (bf16_t*)(ws + WS_Z) + (size_t)8192 * 2048;
        const float* win = P.w_in + (size_t)l * 2048 * DIN;
        cvt_T(tile, win, DIN, 0, 1536, 2048, wt, tb, bid, nb, tid);
        cvt_T(tile, win, DIN, 2304, 3656, 2048, wt + (size_t)1536 * 2048, tb, bid, nb, tid);
        cvt_T(tile, win, DIN, 1536, 768, 2048, wt + (size_t)5376 * 2048, tb, bid, nb, tid);
        cvt_T(tile, P.w_o + (size_t)l * 2048 * 2048, 2048, 0, 2048, 2048, (bf16_t*)(ws + WS_WOT), tb, bid, nb, tid);
        for (int e = 0; e < 16; ++e) {
            const float* wg = P.w_gate + ((size_t)l * 16 + e) * 2048 * 512; const float* wu = P.w_up + ((size_t)l * 16 + e) * 2048 * 512;
            bf16_t* d = (bf16_t*)(ws + WS_WGU) + (size_t)e * 1024 * 2048;
            for (int pn = 0; pn < 4; ++pn) {
                cvt_T(tile, wg, 512, pn * 128, 128, 2048, d + (size_t)(pn * 256) * 2048, tb, bid, nb, tid);
                cvt_T(tile, wu, 512, pn * 128, 128, 2048, d + (size_t)(pn * 256 + 128) * 2048, tb, bid, nb, tid);
            }
            cvt_T(tile, P.w_down + ((size_t)l * 16 + e) * 512 * 2048, 2048, 0, 2048, 512, (bf16_t*)(ws + WS_WDT) + (size_t)e * 2048 * 512, tb, bid, nb, tid);
        }
    }
}

constexpr int SB_KROW = 272, SB_VROW = 144;
constexpr int SB_KBUF = 64 * SB_KROW, SB_VBUF = 128 * SB_VROW;
__device__ __forceinline__ void sb_attn_phase(LAS unsigned char* lds, const bf16_t* __restrict__ Q, const bf16_t* __restrict__ Kg, const bf16_t* __restrict__ Vt, bf16_t* __restrict__ Y,
                              int ubase, int bid, int nb, int tid) {
    const int wid = __builtin_amdgcn_readfirstlane(tid >> 6), lane = tid & 63, ln = lane & 31, hl = lane >> 5;
    const int first = ubase + (((bid - ubase) % nb) + nb) % nb;
    for (int ug = first; ug < ubase + 192; ug += nb) {
        const int u = ug - ubase, qb = 31 - u / 6, h = u % 6;
        const int t0 = qb * 256, tw0 = t0 + 32 * wid, tq = tw0 + ln, twmax = tw0 + 31;
        const int nkt = 4 * qb + 4;
        bf16x8 bq[8];
#pragma unroll
        for (int s = 0; s < 8; ++s) bq[s] = *(const bf16x8*)(Q + (size_t)tq * 768 + h * 128 + 16 * s + 8 * hl);
        f32x16 O[4];
#pragma unroll
        for (int c = 0; c < 4; ++c)
#pragma unroll
            for (int i = 0; i < 16; ++i) O[c][i] = 0.f;
        float R = 0.f;
        u32x4 sk[2], sv[2];
        auto gload = [&](int kt) {
#pragma unroll
            for (int i = 0; i < 2; ++i) { const int c = tid + NTHR * i;
                sk[i] = *(const u32x4*)(Kg + (size_t)(kt * 64 + (c >> 4)) * 768 + h * 128 + (c & 15) * 8);
                sv[i] = *(const u32x4*)(Vt + (size_t)(h * 128 + (c >> 3)) * SEQ + kt * 64 + (c & 7) * 8); }
        };
        auto lstore = [&](int buf) {
#pragma unroll
            for (int i = 0; i < 2; ++i) { const int c = tid + NTHR * i;
                *(LAS u32x4*)(lds + buf * SB_KBUF + (c >> 4) * SB_KROW + (c & 15) * 16) = sk[i];
                *(LAS u32x4*)(lds + 2 * SB_KBUF + buf * SB_VBUF + (c >> 3) * SB_VROW + (c & 7) * 16) = sv[i]; }
        };
        gload(nkt - 1); lstore(0); __syncthreads();
        for (int kt = nkt - 1; kt >= 0; --kt) {
            const int cur = (nkt - 1 - kt) & 1;
            if (kt > 0) gload(kt - 1);
            if (kt * 64 < twmax) {
                LAS unsigned char* kb = lds + cur * SB_KBUF; LAS unsigned char* vb = lds + 2 * SB_KBUF + cur * SB_VBUF;
#pragma unroll
                for (int uu = 1; uu >= 0; --uu) {
                    const int key0 = kt * 64 + 32 * uu;
                    if (key0 < twmax) {
                        f32x16 Sx;
#pragma unroll
                        for (int i = 0; i < 16; ++i) Sx[i] = 0.f;
#pragma unroll
                        for (int s = 0; s < 8; ++s) { const bf16x8 a = *(const LAS bf16x8*)(kb + (32 * uu + ln) * SB_KROW + (16 * s + 8 * hl) * 2); Sx = mfma32(a, bq[s], Sx); }
                        const bool need_mask = (key0 + 31 >= tw0);
                        float lr[16];
#pragma unroll
                        for (int i = 0; i < 16; ++i) {
                            float z = Sx[i];
                            if (need_mask) { const int key = key0 + (i & 3) + 8 * (i >> 2) + 4 * hl; z = (key < tq) ? z : -1e30f; }
                            const float sp = fmaxf(z, 0.f) + __builtin_amdgcn_logf(1.0f + __builtin_amdgcn_exp2f(-fabsf(z)));
                            lr[i] = -sp; Sx[i] = z;
                        }
                        float T[4], PT[4];
#pragma unroll
                        for (int g = 0; g < 4; ++g) { T[g] = (lr[4 * g] + lr[4 * g + 1]) + (lr[4 * g + 2] + lr[4 * g + 3]); PT[g] = __shfl_xor(T[g], 32); }
                        const float W0 = T[0] + PT[0], W1 = T[1] + PT[1], W2 = T[2] + PT[2], W3 = T[3] + PT[3];
                        float Ag[4]; Ag[3] = R; Ag[2] = R + W3; Ag[1] = Ag[2] + W2; Ag[0] = Ag[1] + W1;
                        R = Ag[0] + W0;
                        float pv[16];
#pragma unroll
                        for (int g = 0; g < 4; ++g) {
                            const float base = Ag[g] + (hl == 0 ? PT[g] : 0.f);
                            const float a3 = base, a2 = a3 + lr[4 * g + 3], a1 = a2 + lr[4 * g + 2], a0 = a1 + lr[4 * g + 1];
                            pv[4 * g + 3] = __builtin_amdgcn_exp2f(Sx[4 * g + 3] + lr[4 * g + 3] + a3);
                            pv[4 * g + 2] = __builtin_amdgcn_exp2f(Sx[4 * g + 2] + lr[4 * g + 2] + a2);
                            pv[4 * g + 1] = __builtin_amdgcn_exp2f(Sx[4 * g + 1] + lr[4 * g + 1] + a1);
                            pv[4 * g + 0] = __builtin_amdgcn_exp2f(Sx[4 * g + 0] + lr[4 * g + 0] + a0);
                        }
                        bf16x8 pb[2];
#pragma unroll
                        for (int s2 = 0; s2 < 2; ++s2) { u32x4 w; w.x = cvt_pk_bf16(pv[8 * s2], pv[8 * s2 + 1]); w.y = cvt_pk_bf16(pv[8 * s2 + 2], pv[8 * s2 + 3]);
                            w.z = cvt_pk_bf16(pv[8 * s2 + 4], pv[8 * s2 + 5]); w.w = cvt_pk_bf16(pv[8 * s2 + 6], pv[8 * s2 + 7]); pb[s2] = as_bf16x8(w); }
#pragma unroll
                        for (int c = 0; c < 4; ++c)
#pragma unroll
                            for (int s2 = 0; s2 < 2; ++s2) { const bf16x8 a = *(const LAS bf16x8*)(vb + (32 * c + ln) * SB_VROW + (32 * uu + 16 * s2 + 8 * hl) * 2); O[c] = mfma32(a, pb[s2], O[c]); }
                    }
                }
            }
            if (kt > 0) lstore(cur ^ 1);
            __syncthreads();
        }
#pragma unroll
        for (int c = 0; c < 4; ++c)
#pragma unroll
            for (int g = 0; g < 4; ++g) { u32x2 w; w.x = cvt_pk_bf16(O[c][4 * g], O[c][4 * g + 1]); w.y = cvt_pk_bf16(O[c][4 * g + 2], O[c][4 * g + 3]);
                *(u32x2*)(Y + (size_t)tq * 2048 + h * 128 + 32 * c + 8 * g + 4 * hl) = w; }
    }
}

__constant__ float RET_L2G[4] = {-0.045803689613124735f, -0.022720076500083467f, -0.011315313227834146f, -0.0056465631411421125f};
constexpr int RT_ROW = 272;
constexpr int RT_TILE = 128 * RT_ROW;
__device__ __forceinline__ void rot8(const u32x4 a, const u32x4 b, const f32x2* __restrict__ cs, float sc, float (&o1)[8], float (&o2)[8]) {
#pragma unroll
    for (int j = 0; j < 4; ++j) {
        const float x1l = bflo(a[j]), x1h = bfhi(a[j]), x2l = bflo(b[j]), x2h = bfhi(b[j]);
        const f32x2 c0 = cs[2 * j], c1 = cs[2 * j + 1];
        o1[2 * j] = (x1l * c0.x - x2l * c0.y) * sc; o2[2 * j] = (x1l * c0.y + x2l * c0.x) * sc;
        o1[2 * j + 1] = (x1h * c1.x - x2h * c1.y) * sc; o2[2 * j + 1] = (x1h * c1.y + x2h * c1.x) * sc;
    }
}
__device__ __forceinline__ void ret_kv_phase(LAS unsigned char* lds, const bf16_t* __restrict__ Kr, const bf16_t* __restrict__ Vr, const f32x2* __restrict__ rot, float* __restrict__ KVT,
                             int ubase, int bid, int nb, int tid) {
    const int wid = __builtin_amdgcn_readfirstlane(tid >> 6), lane = tid & 63, ln = lane & 31, hl = lane >> 5;
    LAS unsigned char* vt = lds; LAS unsigned char* kt = lds + RT_TILE;
    const int first = ubase + (((bid - ubase) % nb) + nb) % nb;
    for (int ug = first; ug < ubase + 256; ug += nb) {
        const int u = ug - ubase, h = u >> 6, c = u & 63, j0 = c * 128;
        const float l2g = RET_L2G[h];
#pragma unroll
        for (int i = 0; i < 2; ++i) { const int it = tid + NTHR * i, j = it & 127, dg = it >> 7;
            const u32x4 a = *(const u32x4*)(Kr + (size_t)(j0 + j) * 512 + h * 128 + 8 * dg), b = *(const u32x4*)(Kr + (size_t)(j0 + j) * 512 + h * 128 + 64 + 8 * dg);
            float o1[8], o2[8]; rot8(a, b, rot + (size_t)(j0 + j) * 64 + 8 * dg, 0.08838834764831845f * __builtin_amdgcn_exp2f((float)(127 - j) * l2g), o1, o2);
#pragma unroll
            for (int e = 0; e < 8; e += 2) { const unsigned p1 = cvt_pk_bf16(o1[e], o1[e + 1]), p2 = cvt_pk_bf16(o2[e], o2[e + 1]);
                *(LAS bf16_t*)(kt + (8 * dg + e) * RT_ROW + j * 2) = (bf16_t)(p1 & 0xffffu); *(LAS bf16_t*)(kt + (8 * dg + e + 1) * RT_ROW + j * 2) = (bf16_t)(p1 >> 16);
                *(LAS bf16_t*)(kt + (64 + 8 * dg + e) * RT_ROW + j * 2) = (bf16_t)(p2 & 0xffffu); *(LAS bf16_t*)(kt + (64 + 8 * dg + e + 1) * RT_ROW + j * 2) = (bf16_t)(p2 >> 16); } }
#pragma unroll
        for (int i = 0; i < 4; ++i) { const int it = tid + NTHR * i, j = it & 127, ch = it >> 7;
            const u32x4 a = *(const u32x4*)(Vr + (size_t)(j0 + j) * 512 + h * 128 + 8 * ch);
#pragma unroll
            for (int e = 0; e < 4; ++e) { *(LAS bf16_t*)(vt + (8 * ch + 2 * e) * RT_ROW + j * 2) = (bf16_t)(a[e] & 0xffffu); *(LAS bf16_t*)(vt + (8 * ch + 2 * e + 1) * RT_ROW + j * 2) = (bf16_t)(a[e] >> 16); } }
        __syncthreads();
        const int ce = wid & 3, dh = wid >> 2;
        f32x16 acc[2];
#pragma unroll
        for (int n = 0; n < 2; ++n)
#pragma unroll
            for (int i = 0; i < 16; ++i) acc[n][i] = 0.f;
#pragma unroll
        for (int s = 0; s < 8; ++s) {
            const bf16x8 a = *(const LAS bf16x8*)(vt + (32 * ce + ln) * RT_ROW + (16 * s + 8 * hl) * 2);
#pragma unroll
            for (int n = 0; n < 2; ++n) { const bf16x8 b = *(const LAS bf16x8*)(kt + (64 * dh + 32 * n + ln) * RT_ROW + (16 * s + 8 * hl) * 2); acc[n] = mfma32(a, b, acc[n]); }
        }
        float* out = KVT + (size_t)u * 16384;
#pragma unroll
        for (int n = 0; n < 2; ++n)
#pragma unroll
            for (int i = 0; i < 16; ++i) out[(32 * ce + (i & 3) + 8 * (i >> 2) + 4 * hl) * 128 + 64 * dh + 32 * n + ln] = acc[n][i];
        __syncthreads();
    }
}
__device__ __forceinline__ void ret_scan_phase(const float* __restrict__ KVT, bf16_t* __restrict__ ST, int bid, int nb, int tid) {
    for (int idx = bid * NTHR + tid; idx < 65536; idx += nb * NTHR) {
        const int h = idx >> 14, ed = idx & 16383; const float cd = __builtin_amdgcn_exp2f(128.0f * RET_L2G[h]);
        float s = 0.f;
        for (int c0 = 0; c0 < 64; c0 += 8) {
            float kv[8];
#pragma unroll
            for (int k = 0; k < 8; ++k) kv[k] = KVT[((size_t)(h * 64 + c0 + k)) * 16384 + ed];
#pragma unroll
            for (int k = 0; k < 8; ++k) { ST[((size_t)(h * 64 + c0 + k)) * 16384 + ed] = (bf16_t)(cvt_pk_bf16(s, 0.f) & 0xffffu); s = s * cd + kv[k]; }
        }
    }
}
__device__ __forceinline__ void ret_out_phase(LAS unsigned char* lds, const bf16_t* __restrict__ Qr, const bf16_t* __restrict__ Kr, const bf16_t* __restrict__ Vr, const bf16_t* __restrict__ Gr,
                              const f32x2* __restrict__ rot, const bf16_t* __restrict__ ST, const float* __restrict__ gng, bf16_t* __restrict__ Y,
                              int ubase, int bid, int nb, int tid) {
    const int wid = __builtin_amdgcn_readfirstlane(tid >> 6), lane = tid & 63, ln = lane & 31, hl = lane >> 5;
    LAS unsigned char* kp = lds; LAS unsigned char* vt = lds + RT_TILE;
    const int first = ubase + (((bid - ubase) % nb) + nb) % nb;
    for (int ug = first; ug < ubase + 256; ug += nb) {
        const int u = ug - ubase, h = u >> 6, c = u & 63, j0 = c * 128;
        const float l2g = RET_L2G[h];
#pragma unroll
        for (int i = 0; i < 2; ++i) { const int it = tid + NTHR * i, dg = it & 7, j = it >> 3;
            const u32x4 a = *(const u32x4*)(Kr + (size_t)(j0 + j) * 512 + h * 128 + 8 * dg), b = *(const u32x4*)(Kr + (size_t)(j0 + j) * 512 + h * 128 + 64 + 8 * dg);
            float o1[8], o2[8]; rot8(a, b, rot + (size_t)(j0 + j) * 64 + 8 * dg, 0.08838834764831845f, o1, o2);
            u32x4 w1, w2; w1.x = cvt_pk_bf16(o1[0], o1[1]); w1.y = cvt_pk_bf16(o1[2], o1[3]); w1.z = cvt_pk_bf16(o1[4], o1[5]); w1.w = cvt_pk_bf16(o1[6], o1[7]);
            w2.x = cvt_pk_bf16(o2[0], o2[1]); w2.y = cvt_pk_bf16(o2[2], o2[3]); w2.z = cvt_pk_bf16(o2[4], o2[5]); w2.w = cvt_pk_bf16(o2[6], o2[7]);
            *(LAS u32x4*)(kp + j * RT_ROW + 16 * dg) = w1; *(LAS u32x4*)(kp + j * RT_ROW + 128 + 16 * dg) = w2; }
#pragma unroll
        for (int i = 0; i < 4; ++i) { const int it = tid + NTHR * i, j = it & 127, ch = it >> 7;
            const int pos = (j & ~15) | ((j & 3) + 4 * ((j >> 3) & 1) + 8 * ((j >> 2) & 1));
            const u32x4 a = *(const u32x4*)(Vr + (size_t)(j0 + j) * 512 + h * 128 + 8 * ch);
#pragma unroll
            for (int e = 0; e < 4; ++e) { *(LAS bf16_t*)(vt + (8 * ch + 2 * e) * RT_ROW + pos * 2) = (bf16_t)(a[e] & 0xffffu); *(LAS bf16_t*)(vt + (8 * ch + 2 * e + 1) * RT_ROW + pos * 2) = (bf16_t)(a[e] >> 16); } }
        __syncthreads();
        if (wid < 4) {
            const int il = 32 * wid + ln, tq = j0 + il;
            bf16x8 bq[8];
#pragma unroll
            for (int s = 0; s < 4; ++s) {
                const u32x4 a = *(const u32x4*)(Qr + (size_t)tq * 512 + h * 128 + 16 * s + 8 * hl), b = *(const u32x4*)(Qr + (size_t)tq * 512 + h * 128 + 64 + 16 * s + 8 * hl);
                float o1[8], o2[8]; rot8(a, b, rot + (size_t)tq * 64 + 16 * s + 8 * hl, 1.0f, o1, o2);
                u32x4 w1, w2; w1.x = cvt_pk_bf16(o1[0], o1[1]); w1.y = cvt_pk_bf16(o1[2], o1[3]); w1.z = cvt_pk_bf16(o1[4], o1[5]); w1.w = cvt_pk_bf16(o1[6], o1[7]);
                w2.x = cvt_pk_bf16(o2[0], o2[1]); w2.y = cvt_pk_bf16(o2[2], o2[3]); w2.z = cvt_pk_bf16(o2[4], o2[5]); w2.w = cvt_pk_bf16(o2[6], o2[7]);
                bq[s] = as_bf16x8(w1); bq[s + 4] = as_bf16x8(w2);
            }
            f32x16 O[4];
#pragma unroll
            for (int ce = 0; ce < 4; ++ce)
#pragma unroll
                for (int i = 0; i < 16; ++i) O[ce][i] = 0.f;
            const bf16_t* st = ST + (size_t)u * 16384;
#pragma unroll
            for (int ce = 0; ce < 4; ++ce)
#pragma unroll
                for (int s = 0; s < 8; ++s) { const bf16x8 a = *(const bf16x8*)(st + (size_t)(32 * ce + ln) * 128 + 16 * s + 8 * hl); O[ce] = mfma32(a, bq[s], O[ce]); }
            const float qd = __builtin_amdgcn_exp2f((float)(il + 1) * l2g);
#pragma unroll
            for (int ce = 0; ce < 4; ++ce)
#pragma unroll
                for (int i = 0; i < 16; ++i) O[ce][i] *= qd;
            for (int jb = 0; jb <= wid; ++jb) {
                f32x16 Sx;
#pragma unroll
                for (int i = 0; i < 16; ++i) Sx[i] = 0.f;
#pragma unroll
                for (int s = 0; s < 8; ++s) { const bf16x8 a = *(const LAS bf16x8*)(kp + (32 * jb + ln) * RT_ROW + (16 * s + 8 * hl) * 2); Sx = mfma32(a, bq[s], Sx); }
                float pv[16];
#pragma unroll
                for (int i = 0; i < 16; ++i) { const int jl = 32 * jb + (i & 3) + 8 * (i >> 2) + 4 * hl; const int diff = il - jl;
                    pv[i] = (diff >= 0) ? Sx[i] * __builtin_amdgcn_exp2f((float)diff * l2g) : 0.f; }
                bf16x8 pb[2];
#pragma unroll
                for (int s2 = 0; s2 < 2; ++s2) { u32x4 w; w.x = cvt_pk_bf16(pv[8 * s2], pv[8 * s2 + 1]); w.y = cvt_pk_bf16(pv[8 * s2 + 2], pv[8 * s2 + 3]);
                    w.z = cvt_pk_bf16(pv[8 * s2 + 4], pv[8 * s2 + 5]); w.w = cvt_pk_bf16(pv[8 * s2 + 6], pv[8 * s2 + 7]); pb[s2] = as_bf16x8(w); }
#pragma unroll
                for (int ce = 0; ce < 4; ++ce)
#pragma unroll
                    for (int s2 = 0; s2 < 2; ++s2) { const bf16x8 a = *(const LAS bf16x8*)(vt + (32 * ce + ln) * RT_ROW + (32 * jb + 16 * s2 + 8 * hl) * 2); O[ce] = mfma32(a, pb[s2], O[ce]); }
            }
            float sm = 0.f;
#pragma unroll
            for (int ce = 0; ce < 4; ++ce)
#pragma unroll
                for (int i = 0; i < 16; ++i) sm += O[ce][i];
            sm += __shfl_xor(sm, 32);
            const float mu = sm * (1.0f / 128.0f);
            float sq = 0.f;
#pragma unroll
            for (int ce = 0; ce < 4; ++ce)
#pragma unroll
                for (int i = 0; i < 16; ++i) { const float d = O[ce][i] - mu; sq += d * d; }
            sq += __shfl_xor(sq, 32);
            const float rstd = __builtin_amdgcn_rsqf(sq * (1.0f / 128.0f) + 1e-6f);
#pragma unroll
            for (int ce = 0; ce < 4; ++ce)
#pragma unroll
                for (int g = 0; g < 4; ++g) {
                    const int e0 = 32 * ce + 8 * g + 4 * hl;
                    const u32x2 gv = *(const u32x2*)(Gr + (size_t)tq * 512 + h * 128 + e0); const f32x4 gn = *(const f32x4*)(gng + h * 128 + e0);
                    float gg[4] = {bflo(gv.x), bfhi(gv.x), bflo(gv.y), bfhi(gv.y)}; float o[4];
#pragma unroll
                    for (int e = 0; e < 4; ++e) { const float y = (O[ce][4 * g + e] - mu) * rstd * gn[e]; o[e] = y * gg[e] / (1.0f + __expf(-gg[e])); }
                    u32x2 w; w.x = cvt_pk_bf16(o[0], o[1]); w.y = cvt_pk_bf16(o[2], o[3]);
                    *(u32x2*)(Y + (size_t)tq * 2048 + 768 + h * 128 + e0) = w;
                }
        }
        __syncthreads();
    }
}

__device__ __forceinline__ void cn_phase(const bf16_t* __restrict__ CKV, const float* __restrict__ g, bf16_t* __restrict__ CN, int bid, int nb, int tid) {
    const int wid = tid >> 6, lane = tid & 63;
    const f32x4 gv = *(const f32x4*)(g + 4 * lane);
    for (int t = bid * 8 + wid; t < SEQ; t += nb * 8) {
        const u32x2 vv = *(const u32x2*)(CKV + (size_t)t * 256 + 4 * lane); const f32x4 v = (f32x4){bflo(vv.x), bfhi(vv.x), bflo(vv.y), bfhi(vv.y)};
        const float ss = wave_sum(v[0] * v[0] + v[1] * v[1] + v[2] * v[2] + v[3] * v[3]);
        const float rs = __builtin_amdgcn_rsqf(ss * (1.0f / 256.0f) + 1e-6f);
        u32x2 w; w.x = cvt_pk_bf16(v[0] * rs * gv[0], v[1] * rs * gv[1]); w.y = cvt_pk_bf16(v[2] * rs * gv[2], v[3] * rs * gv[3]);
        *(u32x2*)(CN + (size_t)t * 256 + 4 * lane) = w;
    }
}
__device__ __forceinline__ void score_phase(const bf16_t* __restrict__ Qi, const bf16_t* __restrict__ KW, float* __restrict__ SC, int vbase, int bid, int nb, int tid) {
    const int wid = tid >> 6, lane = tid & 63, ln = lane & 31, hl = lane >> 5;
    const int nw = nb * 8, NV = 8320;
    int v = vbase + ((((bid * 8 + wid) - vbase) % nw) + nw) % nw;
    for (; v < vbase + NV; v += nw) {
        const int vv = v - vbase, tri = vv >> 2, sub = vv & 3;
        int q4 = (int)((__builtin_sqrtf(8.0f * (float)tri + 1.0f) - 1.0f) * 0.5f);
        while ((q4 + 1) * (q4 + 2) / 2 <= tri) ++q4;
        while (q4 * (q4 + 1) / 2 > tri) --q4;
        const int kt = tri - q4 * (q4 + 1) / 2, qblk = 4 * q4 + sub, tq = 32 * qblk + ln, kbase = 128 * kt;
        bf16x8 ka[4][4];
#pragma unroll
        for (int uu = 0; uu < 4; ++uu)
#pragma unroll
            for (int s = 0; s < 4; ++s) ka[uu][s] = *(const bf16x8*)(KW + (size_t)(kbase + 32 * uu + ln) * 256 + 16 * s + 8 * hl);
        f32x16 sc[4];
#pragma unroll
        for (int uu = 0; uu < 4; ++uu)
#pragma unroll
            for (int i = 0; i < 16; ++i) sc[uu][i] = 0.f;
#pragma unroll 1
        for (int hp = 0; hp < 4; ++hp) {
            bf16x8 qb[2][4];
#pragma unroll
            for (int hh = 0; hh < 2; ++hh)
#pragma unroll
                for (int s = 0; s < 4; ++s) qb[hh][s] = *(const bf16x8*)(Qi + (size_t)tq * 512 + (2 * hp + hh) * 64 + 16 * s + 8 * hl);
            const unsigned wpk = *(const unsigned*)(KW + (size_t)tq * 256 + 64 + 2 * hp); const float wa = bflo(wpk) * IDX_SCALE, wb = bfhi(wpk) * IDX_SCALE;
#pragma unroll
            for (int uu = 0; uu < 4; ++uu)
#pragma unroll
                for (int hh = 0; hh < 2; ++hh) {
                    f32x16 t;
#pragma unroll
                    for (int i = 0; i < 16; ++i) t[i] = 0.f;
#pragma unroll
                    for (int s = 0; s < 4; ++s) t = mfma32(ka[uu][s], qb[hh][s], t);
                    const float w = hh ? wb : wa;
#pragma unroll
                    for (int i = 0; i < 16; ++i) sc[uu][i] += w * fmaxf(t[i], 0.f);
                }
        }
#pragma unroll
        for (int uu = 0; uu < 4; ++uu)
#pragma unroll
            for (int g = 0; g < 4; ++g)
                { const int key0 = kbase + 32 * uu + 8 * g + 4 * hl;
                  if (key0 <= (tq | 3)) *(f32x4*)(SC + sc_rowoff(tq) + key0) = (f32x4){sc[uu][4 * g], sc[uu][4 * g + 1], sc[uu][4 * g + 2], sc[uu][4 * g + 3]}; }
    }
}
constexpr int DS_ROW = 544;
constexpr int DS_TILE = 32 * DS_ROW;
__device__ __forceinline__ void dsa_phase(LAS unsigned char* lds, const float* __restrict__ SC, const bf16_t* __restrict__ CN, const bf16_t* __restrict__ QP, bf16_t* __restrict__ OP, int bid, int nb, int tid) {
    const int wid = __builtin_amdgcn_readfirstlane(tid >> 6), lane = tid & 63, hn = lane & 15, g = lane >> 4;
    LAS unsigned char* tile = lds + wid * DS_TILE;
    LAS unsigned short* list = (LAS unsigned short*)(lds + 8 * DS_TILE + wid * 512);
    const int gw = bid * 8 + wid, nw = nb * 8;
    for (int rr = gw; rr < SEQ; rr += nw) {
        const int blk = rr / nw, pos = rr % nw; const int t = (blk & 1) ? (blk * nw + (nw - 1 - pos)) : rr;
        const int n = t + 1; int nvalid;
        if (n <= 256) {
            nvalid = n;
#pragma unroll
            for (int i = 0; i < 4; ++i) { const int e = i * 64 + lane; list[e] = (unsigned short)(e < n ? e : t); }
        } else {
            nvalid = 256;
            const int nI = (n + 63) >> 6;
            unsigned key[128];
            const float* row = SC + sc_rowoff(t);
#pragma unroll
            for (int i = 0; i < 128; ++i) {
                unsigned k = 0u;
                if (i < nI) { const int e = i * 64 + lane; if (e < n) { const unsigned b = __float_as_uint(row[e]); k = (b & 0x80000000u) ? ~b : (b | 0x80000000u); } }
                key[i] = k;
            }
            unsigned T = 0u;
            for (int bit = 31; bit >= 0; --bit) {
                const unsigned cand = T | (1u << bit); int cnt = 0;
#pragma unroll
                for (int i0 = 0; i0 < 128; i0 += 16) if (i0 < nI) {
#pragma unroll
                    for (int i = i0; i < i0 + 16; ++i) cnt += __popcll(__ballot(key[i] >= cand));
                }
                if (cnt >= 256) T = cand;
            }
            int cgt = 0;
#pragma unroll
            for (int i0 = 0; i0 < 128; i0 += 16) if (i0 < nI) {
#pragma unroll
                for (int i = i0; i < i0 + 16; ++i) cgt += __popcll(__ballot(key[i] > T));
            }
            const int need = 256 - cgt;
            int obase = 0, ebase = 0; const unsigned long long ltm = (1ull << lane) - 1ull;
#pragma unroll
            for (int i0 = 0; i0 < 128; i0 += 16) if (i0 < nI) {
#pragma unroll
                for (int i = i0; i < i0 + 16; ++i) {
                    const bool gt = key[i] > T, eq = key[i] == T;
                    const unsigned long long meq = __ballot(eq);
                    const bool selq = gt || (eq && (ebase + __popcll(meq & ltm) < need));
                    const unsigned long long ms = __ballot(selq);
                    if (selq) list[obase + __popcll(ms & ltm)] = (unsigned short)(i * 64 + lane);
                    obase += __popcll(ms); ebase += __popcll(meq);
                }
            }
        }
        bf16x8 bq[8];
#pragma unroll
        for (int s = 0; s < 8; ++s) { u32x4 v = (u32x4){0u, 0u, 0u, 0u}; if (hn < 6) v = *(const u32x4*)(QP + (size_t)t * 1536 + hn * 256 + 32 * s + 8 * g); bq[s] = as_bf16x8(v); }
        f32x4 O[16];
#pragma unroll
        for (int c = 0; c < 16; ++c) O[c] = (f32x4){0.f, 0.f, 0.f, 0.f};
        float mrun = -1e30f, lsum = 0.f;
        const int nch = (nvalid + 31) >> 5;
        for (int ch = 0; ch < nch; ++ch) {
#pragma unroll 1
            for (int hf = 0; hf < 2; ++hf) {
                u32x4 gv[8];
#pragma unroll
                for (int it = 0; it < 8; ++it) { const int idx = list[ch * 32 + 16 * hf + 2 * it + (lane >> 5)]; gv[it] = *(const u32x4*)(CN + (size_t)idx * 256 + (lane & 31) * 8); }
#pragma unroll
                for (int it = 0; it < 8; ++it) *(LAS u32x4*)(tile + (16 * hf + 2 * it + (lane >> 5)) * DS_ROW + (lane & 31) * 16) = gv[it];
            }
            f32x4 st[2];
#pragma unroll
            for (int rb = 0; rb < 2; ++rb) { st[rb] = (f32x4){0.f, 0.f, 0.f, 0.f};
#pragma unroll
                for (int s = 0; s < 8; ++s) { const bf16x8 a = *(const LAS bf16x8*)(tile + (16 * rb + hn) * DS_ROW + (32 * s + 8 * g) * 2); st[rb] = mfma16(a, bq[s], st[rb]); } }
            float mx = -1e30f;
#pragma unroll
            for (int rb = 0; rb < 2; ++rb)
#pragma unroll
                for (int i = 0; i < 4; ++i) { const int slot = ch * 32 + 16 * rb + 4 * g + i; st[rb][i] = (slot < nvalid) ? st[rb][i] : -1e30f; mx = fmaxf(mx, st[rb][i]); }
            mx = fmaxf(mx, __shfl_xor(mx, 16)); mx = fmaxf(mx, __shfl_xor(mx, 32));
            const float mnew = fmaxf(mrun, mx), alpha = __builtin_amdgcn_exp2f(mrun - mnew);
            float ps = 0.f; float p[8];
#pragma unroll
            for (int rb = 0; rb < 2; ++rb)
#pragma unroll
                for (int i = 0; i < 4; ++i) { p[4 * rb + i] = __builtin_amdgcn_exp2f(st[rb][i] - mnew); ps += p[4 * rb + i]; }
            ps += __shfl_xor(ps, 16); ps += __shfl_xor(ps, 32);
            lsum = lsum * alpha + ps; mrun = mnew;
#pragma unroll
            for (int c = 0; c < 16; ++c) O[c] *= alpha;
            u32x4 pw; pw.x = cvt_pk_bf16(p[0], p[1]); pw.y = cvt_pk_bf16(p[2], p[3]); pw.z = cvt_pk_bf16(p[4], p[5]); pw.w = cvt_pk_bf16(p[6], p[7]);
            const bf16x8 pb = as_bf16x8(pw);
            LAS unsigned char* a_lo = tile + (4 * g + (hn >> 2)) * DS_ROW + 8 * (hn & 3);
            LAS unsigned char* a_hi = a_lo + 16 * DS_ROW;
#pragma unroll
            for (int c = 0; c < 16; ++c) {
                const bf16x4 lo = __builtin_amdgcn_ds_read_tr16_b64_v4i16((LAS bf16x4*)(a_lo + 32 * c));
                const bf16x4 hi = __builtin_amdgcn_ds_read_tr16_b64_v4i16((LAS bf16x4*)(a_hi + 32 * c));
                const bf16x8 a = __builtin_shufflevector(lo, hi, 0, 1, 2, 3, 4, 5, 6, 7);
                O[c] = mfma16(a, pb, O[c]);
            }
        }
        const float inv = 1.0f / lsum;
        if (hn < 6) {
#pragma unroll
            for (int c = 0; c < 16; ++c) { u32x2 w; w.x = cvt_pk_bf16(O[c][0] * inv, O[c][1] * inv); w.y = cvt_pk_bf16(O[c][2] * inv, O[c][3] * inv);
                *(u32x2*)(OP + (size_t)t * 1536 + hn * 256 + 16 * c + 4 * g) = w; }
        }
    }
}

constexpr int RW_STRIDE = 2052;
__device__ __forceinline__ void ln_router_phase(LAS unsigned char* lds, float* X1  , const float* __restrict__ lg, const float* __restrict__ lb, const float* __restrict__ wr,
                                int* __restrict__ EID, float* __restrict__ GW, unsigned* __restrict__ ctl, int bid, int nb, int tid) {
    const int wid = tid >> 6, lane = tid & 63;
    LAS float* W = (LAS float*)lds; LAS int* tokE = (LAS int*)(lds + 16 * RW_STRIDE * 4);
    for (int idx = tid; idx < 2048 * 16; idx += NTHR) W[(idx & 15) * RW_STRIDE + (idx >> 4)] = wr[idx];
    __syncthreads();
    for (int cb = bid; cb < 256; cb += nb) {
        for (int k4 = 0; k4 < 4; ++k4) {
            const int tl = 4 * wid + k4, t = 32 * cb + tl;
            f32x4 x[8]; float s = 0.f;
#pragma unroll
            for (int k = 0; k < 8; ++k) { x[k] = *(const f32x4*)(X1 + (size_t)t * 2048 + 256 * k + 4 * lane); s += (x[k][0] + x[k][1]) + (x[k][2] + x[k][3]); }
            const float mu = wave_sum(s) * (1.0f / 2048.0f);
            float q = 0.f;
#pragma unroll
            for (int k = 0; k < 8; ++k) { const f32x4 d = x[k] - mu; q += (d[0] * d[0] + d[1] * d[1]) + (d[2] * d[2] + d[3] * d[3]); }
            const float rstd = __builtin_amdgcn_rsqf(wave_sum(q) * (1.0f / 2048.0f) + 1e-5f);
#pragma unroll
            for (int k = 0; k < 8; ++k) { const f32x4 gg = *(const f32x4*)(lg + 256 * k + 4 * lane), bb = *(const f32x4*)(lb + 256 * k + 4 * lane);
                x[k] = (x[k] - mu) * rstd * gg + bb;
                *(f32x4*)(X1 + (size_t)t * 2048 + 256 * k + 4 * lane) = x[k]; }
            float ex[16];
#pragma unroll
            for (int e = 0; e < 16; ++e) { float p = 0.f;
#pragma unroll
                for (int k = 0; k < 8; ++k) { const f32x4 w = *(const LAS f32x4*)(W + e * RW_STRIDE + 256 * k + 4 * lane); p += (x[k][0] * w[0] + x[k][1] * w[1]) + (x[k][2] * w[2] + x[k][3] * w[3]); }
                ex[e] = wave_sum(p); }
            float mx = ex[0];
#pragma unroll
            for (int e = 1; e < 16; ++e) mx = fmaxf(mx, ex[e]);
#pragma unroll
            for (int e = 0; e < 16; ++e) ex[e] = __expf(ex[e] - mx);
            float gs[4];
#pragma unroll
            for (int g = 0; g < 4; ++g) { const float a = ex[4 * g], b = ex[4 * g + 1], c = ex[4 * g + 2], d = ex[4 * g + 3];
                const float h1 = fmaxf(a, b), l1 = fminf(a, b), h2 = fmaxf(c, d), l2 = fminf(c, d);
                gs[g] = fmaxf(h1, h2) + fmaxf(fminf(h1, h2), fmaxf(l1, l2)); }
            int gsel = 0; float gbest = gs[0];
#pragma unroll
            for (int g = 1; g < 4; ++g) if (gs[g] > gbest) { gbest = gs[g]; gsel = g; }
            float v[4];
#pragma unroll
            for (int j = 0; j < 4; ++j) v[j] = gsel == 0 ? ex[j] : (gsel == 1 ? ex[4 + j] : (gsel == 2 ? ex[8 + j] : ex[12 + j]));
            int i0 = 0; float v0 = v[0];
#pragma unroll
            for (int j = 1; j < 4; ++j) if (v[j] > v0) { v0 = v[j]; i0 = j; }
            int i1 = (i0 + 1) & 3; float v1 = -1.f;
#pragma unroll
            for (int j = 0; j < 4; ++j) if (j != i0 && v[j] > v1) { v1 = v[j]; i1 = j; }
            const float inv = 1.0f / (v0 + v1);
            if (lane == 0) { const int e0 = 4 * gsel + i0, e1 = 4 * gsel + i1; tokE[2 * tl] = e0; tokE[2 * tl + 1] = e1;
                EID[2 * t] = e0; EID[2 * t + 1] = e1; GW[2 * t] = v0 * inv; GW[2 * t + 1] = v1 * inv; }
        }
        __syncthreads();
        if (tid < 16) { int c = 0; for (int i = 0; i < 64; ++i) c += (tokE[i] == tid) ? 1 : 0; ctl[CW_BCNT + cb * 16 + tid] = (unsigned)c; }
        __syncthreads();
    }
}
__device__ __forceinline__ void dispatch_phase(LAS unsigned char* lds, const float* __restrict__ X1, const int* __restrict__ EID, const float* __restrict__ GW, int* __restrict__ SLOT, float* __restrict__ SGW,
                               bf16_t* __restrict__ XS, unsigned* __restrict__ ctl, int bid, int nb, int tid) {
    LAS int* tot = (LAS int*)lds; LAS int* pre = tot + 16; LAS int* off = tot + 32; LAS int* slot = tot + 64;
    for (int cb = bid; cb < 256; cb += nb) {
        if (tid < 16) { int tt = 0, pp = 0;
            for (int b = 0; b < 256; ++b) { const int c = (int)ctl[CW_BCNT + b * 16 + tid]; tt += c; pp += (b < cb) ? c : 0; }
            tot[tid] = tt; pre[tid] = pp; }
        __syncthreads();
        if (tid == 0) { int base = 0;
            for (int e = 0; e < 16; ++e) { off[e] = base + pre[e]; const int nt = (tot[e] + 255) >> 8;
                if (cb == 0) for (int k = 0; k < nt; ++k) ctl[CW_TEXP + (base >> 8) + k] = (unsigned)e;
                base += nt << 8; }
            if (cb == 0) ctl[CW_NT] = (unsigned)(base >> 8); }
        __syncthreads();
        if (tid < 64) slot[tid] = XS_ROWS - 1;
        __syncthreads();
        if (tid < 16) { int p = off[tid]; for (int i = 0; i < 64; ++i) if (EID[64 * cb + i] == tid) slot[i] = p++; }
        __syncthreads();
        if (tid < 64) { const int sl = slot[tid]; SLOT[64 * cb + tid] = sl; SGW[sl] = GW[64 * cb + tid]; }
        for (int pr = 0; pr < 64; ++pr) { const int t = 32 * cb + (pr >> 1), sl = slot[pr];
            const f32x4 v = *(const f32x4*)(X1 + (size_t)t * 2048 + tid * 4);
            u32x2 w; w.x = cvt_pk_bf16(v[0], v[1]); w.y = cvt_pk_bf16(v[2], v[3]); *(u32x2*)(XS + (size_t)sl * 2048 + tid * 4) = w; }
        __syncthreads();
    }
}
__device__ __forceinline__ void combine_ln2_phase(const float* __restrict__ X1, const bf16_t* __restrict__ DN, const int* __restrict__ SLOT, const float* __restrict__ lg, const float* __restrict__ lb,
                                  float* __restrict__ outF, bf16_t* __restrict__ outB, int bid, int nb, int tid) {
    const int wid = tid >> 6, lane = tid & 63;
    for (int t = bid * 8 + wid; t < SEQ; t += nb * 8) {
        const int s0 = SLOT[2 * t], s1 = SLOT[2 * t + 1];
        f32x4 x[8]; float s = 0.f;
#pragma unroll
        for (int k = 0; k < 8; ++k) { const f32x4 a = *(const f32x4*)(X1 + (size_t)t * 2048 + 256 * k + 4 * lane);
            const u32x2 d0 = *(const u32x2*)(DN + (size_t)s0 * 2048 + 256 * k + 4 * lane), d1 = *(const u32x2*)(DN + (size_t)s1 * 2048 + 256 * k + 4 * lane);
            x[k][0] = a[0] * ALPHA + (bflo(d0.x) + bflo(d1.x)); x[k][1] = a[1] * ALPHA + (bfhi(d0.x) + bfhi(d1.x));
            x[k][2] = a[2] * ALPHA + (bflo(d0.y) + bflo(d1.y)); x[k][3] = a[3] * ALPHA + (bfhi(d0.y) + bfhi(d1.y));
            s += (x[k][0] + x[k][1]) + (x[k][2] + x[k][3]); }
        const float mu = wave_sum(s) * (1.0f / 2048.0f);
        float q = 0.f;
#pragma unroll
        for (int k = 0; k < 8; ++k) { const f32x4 d = x[k] - mu; q += (d[0] * d[0] + d[1] * d[1]) + (d[2] * d[2] + d[3] * d[3]); }
        const float rstd = __builtin_amdgcn_rsqf(wave_sum(q) * (1.0f / 2048.0f) + 1e-5f);
#pragma unroll
        for (int k = 0; k < 8; ++k) { const f32x4 gg = *(const f32x4*)(lg + 256 * k + 4 * lane), bb = *(const f32x4*)(lb + 256 * k + 4 * lane);
            const f32x4 y = (x[k] - mu) * rstd * gg + bb;
            *(f32x4*)(outF + (size_t)t * 2048 + 256 * k + 4 * lane) = y;
            if (outB) { u32x2 w; w.x = cvt_pk_bf16(y[0], y[1]); w.y = cvt_pk_bf16(y[2], y[3]); *(u32x2*)(outB + (size_t)t * 2048 + 256 * k + 4 * lane) = w; } }
    }
}

#define IN(k) (P.ph_lo <= (k) && (k) < P.ph_hi)
#define SEAM(k) do { if (IN(k) && IN((k) + 1)) xcd_barrier(bar); } while (0)
#define LAUNDER() int tid = tid0, bid = bid0; unsigned char* ws = P.ws; asm volatile("" : "+v"(tid)); asm volatile("" : "+s"(bid)); asm volatile("" : "+s"(ws)); unsigned* ctl = (unsigned*)(ws + WS_CTL);
template <int l> __device__ __forceinline__ void layer_phases(const Params& P, LAS unsigned char* lds, const XcdBarrier& bar, const int tid0, const int bid0, const int nb) {
        constexpr int pb = 1 + 10 * l;
        if (IN(pb + 0)) {
            LAUNDER()
            ProjSched S{(const char*)(ws + WS_Z), nb, bid}; ProjEpi E{ws};
            pg8::gemm_phase(lds, pg8::Dims{2048, 2048, 2048}, S, E, tid);
        } SEAM(pb + 0);
        if (IN(pb + 1)) {
            LAUNDER()
            sb_attn_phase(lds, (const bf16_t*)(ws + WS_QSB), (const bf16_t*)(ws + WS_KSB), (const bf16_t*)(ws + WS_VT), (bf16_t*)(ws + WS_YCAT), 0, bid, nb, tid);
            ret_kv_phase(lds, (const bf16_t*)(ws + WS_KR), (const bf16_t*)(ws + WS_VR), (const f32x2*)(ws + WS_ROT), (float*)(ws + WS_KVT), 192, bid, nb, tid);
            cn_phase((const bf16_t*)(ws + WS_CKV), P.kv_norm_g + l * 256, (bf16_t*)(ws + WS_CN), bid, nb, tid);
            { GridSched S{(const char*)(ws + WS_QD), (const char*)(ws + WS_WABS), 32, 2, 3, (size_t)256 * 768 * 2, (size_t)256 * 256 * 2, (size_t)256 * 2, (size_t)512 * 256 * 2, nb, (bid + 64) % nb};
              Bf16Epi E{(bf16_t*)(ws + WS_QP), 1536, 512, SB_QSCALE};
              pg8::gemm_phase(lds, pg8::Dims{256, 768, 256}, S, E, tid); }
            score_phase((const bf16_t*)(ws + WS_QI), (const bf16_t*)(ws + WS_KW), (float*)(ws + WS_SC), 0, bid, nb, tid);
        } SEAM(pb + 1);
        if (IN(pb + 2)) {
            LAUNDER()
            ret_scan_phase((const float*)(ws + WS_KVT), (bf16_t*)(ws + WS_ST), bid, nb, tid);
            dsa_phase(lds, (const float*)(ws + WS_SC), (const bf16_t*)(ws + WS_CN), (const bf16_t*)(ws + WS_QP), (bf16_t*)(ws + WS_OP), bid, nb, tid);
        } SEAM(pb + 2);
        if (IN(pb + 3)) {
            LAUNDER()
            ret_out_phase(lds, (const bf16_t*)(ws + WS_QR), (const bf16_t*)(ws + WS_KR), (const bf16_t*)(ws + WS_VR), (const bf16_t*)(ws + WS_GR), (const f32x2*)(ws + WS_ROT),
                          (const bf16_t*)(ws + WS_ST), P.ret_gn_g + l * 512, (bf16_t*)(ws + WS_YCAT), 0, bid, nb, tid);
            { GridSched S{(const char*)(ws + WS_OP), (const char*)(ws + WS_WUVP), 32, 1, 3, (size_t)256 * 1536 * 2, (size_t)256 * 512 * 2, (size_t)512 * 2, (size_t)256 * 512 * 2, nb, bid};
              Bf16Epi E{(bf16_t*)(ws + WS_YCAT) + 1280, 2048, 256, 1.0f};
              pg8::gemm_phase(lds, pg8::Dims{512, 1536, 512}, S, E, tid); }
        } SEAM(pb + 3);
        if (IN(pb + 4)) {
            LAUNDER()
            GridSched S{(const char*)(ws + WS_YCAT), (const char*)(ws + WS_WOT), 32, 8, 1, TS2048, TS2048, 0, 0, nb, bid};
            ResF32Epi E{(float*)(ws + WS_X1), l ? (const float*)P.out : P.x};
            pg8::gemm_phase(lds, pg8::Dims{2048, 2048, 2048}, S, E, tid);
        } SEAM(pb + 4);
        if (IN(pb + 5)) {
            LAUNDER()
            ln_router_phase(lds, (float*)(ws + WS_X1), P.ln1_g + l * 2048, P.ln1_b + l * 2048, P.w_router, (int*)(ws + WS_EID), (float*)(ws + WS_GW), ctl, bid, nb, tid);
        } SEAM(pb + 5);
        if (IN(pb + 6)) {
            LAUNDER()
            dispatch_phase(lds, (const float*)(ws + WS_X1), (const int*)(ws + WS_EID), (const float*)(ws + WS_GW), (int*)(ws + WS_SLOT), (float*)(ws + WS_SGW), (bf16_t*)(ws + WS_XS), ctl, bid, nb, tid);
        } SEAM(pb + 6);
        if (IN(pb + 7)) {
            LAUNDER()
            MoeSched S{(const char*)(ws + WS_XS), (const char*)(ws + WS_WGU), ctl, 4, TS2048, TS2048, nb, bid};
            GateUpEpi E{(bf16_t*)(ws + WS_ACT), (const float*)(ws + WS_SGW)};
            pg8::gemm_phase(lds, pg8::Dims{2048, 2048, 2048}, S, E, tid);
        } SEAM(pb + 7);
        if (IN(pb + 8)) {
            LAUNDER()
            MoeSched S{(const char*)(ws + WS_ACT), (const char*)(ws + WS_WDT), ctl, 8, (size_t)256 * 512 * 2, (size_t)256 * 512 * 2, nb, bid};
            DownEpi E{(bf16_t*)(ws + WS_DN)};
            pg8::gemm_phase(lds, pg8::Dims{512, 512, 512}, S, E, tid);
        } SEAM(pb + 8);
        if (IN(pb + 9)) {
            LAUNDER()
            combine_ln2_phase((const float*)(ws + WS_X1), (const bf16_t*)(ws + WS_DN), (const int*)(ws + WS_SLOT), P.ln2_g + l * 2048, P.ln2_b + l * 2048,
                              P.out, l ? (bf16_t*)nullptr : (bf16_t*)(ws + WS_Z), bid, nb, tid);
            if (l == 0) p0_weights(P, ws, lds, 1, bid, nb, tid);
        } SEAM(pb + 9);
}
constexpr int NPHASE = 21;
__global__ void __launch_bounds__(NTHR, 2) fwd_kernel(Params P) {
    extern __shared__ __attribute__((aligned(16))) unsigned char smem[];
    LAS unsigned char* lds = (LAS unsigned char*)smem;
    const int tid0 = threadIdx.x, bid0 = blockIdx.x, nb = gridDim.x;
    unsigned* ctl0 = (unsigned*)(P.ws + WS_CTL);
    volatile LAS unsigned* bst = (volatile LAS unsigned*)(lds + LDS_BYTES - 16);
    const bool multi = (P.ph_hi - P.ph_lo) > 1;
    if (tid0 == 0) { bst[0] = 0u; bst[1] = 0u; bst[2] = 0u; bst[3] = 0u; }
    __syncthreads();
    XcdBarrier bar; bar.bar = ctl0 + CW_BAR; bar.x = 0; bar.st = bst;
    if (multi) bar = xcd_barrier_post(ctl0 + CW_BAR, bst);
    if (IN(0)) { LAUNDER() (void)ctl; p0_common(P, ws, bid, nb, tid); p0_weights(P, ws, lds, 0, bid, nb, tid); } SEAM(0);
    layer_phases<0>(P, lds, bar, tid0, bid0, nb);
    layer_phases<1>(P, lds, bar, tid0, bid0, nb);
#undef IN
#undef SEAM
}

#ifndef N_LAUNCHES
#define N_LAUNCHES 1
#endif
extern "C" void kernel_launch(void* const* d_in, const int* in_sizes, int n_in, void* d_out, int out_size, void* d_ws, size_t ws_size, hipStream_t stream) {
    static int grid = 0;
    if (grid == 0) {
        int dev = 0, cus = 0, per_cu = 0;
        if (n_in != 14 || ws_size < WS_END) { fprintf(stderr, "kernel_launch: bad arguments (n_in %d, ws %zu < %zu)\n", n_in, ws_size, (size_t)WS_END); grid = -1; return; }
        if (hipGetDevice(&dev) != hipSuccess || hipDeviceGetAttribute(&cus, hipDeviceAttributeMultiprocessorCount, dev) != hipSuccess) { grid = -1; return; }
        if (hipFuncSetAttribute((const void*)fwd_kernel, hipFuncAttributeMaxDynamicSharedMemorySize, LDS_BYTES) != hipSuccess) { fprintf(stderr, "kernel_launch: hipFuncSetAttribute failed\n"); grid = -1; return; }
        if (hipOccupancyMaxActiveBlocksPerMultiprocessor(&per_cu, (const void*)fwd_kernel, NTHR, LDS_BYTES) != hipSuccess || per_cu < 1) fprintf(stderr, "kernel_launch: occupancy query says %d\n", per_cu);
        (void)hipGetLastError();
        grid = cus;
    }
    if (grid < 0) return;
    (void)hipMemsetAsync((char*)d_ws + WS_CTL, 0, CTL_BYTES, stream);
    Params p{};
    p.x = (const float*)d_in[0]; p.w_in = (const float*)d_in[1]; p.w_kv_up = (const float*)d_in[2]; p.kv_norm_g = (const float*)d_in[3]; p.ret_gn_g = (const float*)d_in[4];
    p.w_o = (const float*)d_in[5]; p.ln1_g = (const float*)d_in[6]; p.ln1_b = (const float*)d_in[7]; p.w_router = (const float*)d_in[8];
    p.w_gate = (const float*)d_in[9]; p.w_up = (const float*)d_in[10]; p.w_down = (const float*)d_in[11]; p.ln2_g = (const float*)d_in[12]; p.ln2_b = (const float*)d_in[13];
    p.out = (float*)d_out; p.ws = (unsigned char*)d_ws;
    if (N_LAUNCHES == 1) { p.ph_lo = 0; p.ph_hi = NPHASE; hipLaunchKernelGGL(fwd_kernel, dim3(grid), dim3(NTHR), LDS_BYTES, stream, p); }
    else for (int k = 0; k < NPHASE; ++k) { p.ph_lo = k; p.ph_hi = k + 1; hipLaunchKernelGGL(fwd_kernel, dim3(grid), dim3(NTHR), LDS_BYTES, stream, p); }
}
```

```cpp
#include <hip/hip_runtime.h>
#include <stdint.h>
#include <stdio.h>

#define LAS __attribute__((address_space(3)))
typedef unsigned short bf16_t;
typedef short bf16x8 __attribute__((ext_vector_type(8)));
typedef short bf16x4 __attribute__((ext_vector_type(4)));
typedef float f32x2 __attribute__((ext_vector_type(2)));
typedef float f32x4 __attribute__((ext_vector_type(4)));
typedef float f32x16 __attribute__((ext_vector_type(16)));
typedef unsigned u32x2 __attribute__((ext_vector_type(2)));
typedef unsigned u32x4 __attribute__((ext_vector_type(4)));

constexpr int SEQ = 8192, DM = 2048, DIN = 5960, NTHR = 512;
constexpr float ALPHA = 1.41421356237309515f;
constexpr float LOG2E = 1.44269504088896341f;
constexpr float SB_QSCALE = 0.08838834764831845f * LOG2E;
constexpr float IDX_SCALE = 0.04419417382415922f;
constexpr int LDS_BYTES = 147456;

constexpr size_t WS_CTL = 0, CTL_BYTES = 65536;
constexpr size_t Z_BYTES = (size_t)(8192 + 6144) * 2048 * 2;
constexpr size_t WS_Z = WS_CTL + CTL_BYTES;
constexpr size_t WS_ROT = WS_Z + Z_BYTES;
constexpr size_t WS_WOT = WS_ROT + (size_t)8192 * 64 * 8;
constexpr size_t WS_WGU = WS_WOT + (size_t)2048 * 2048 * 2;
constexpr size_t WS_WDT = WS_WGU + (size_t)16 * 1024 * 2048 * 2;
constexpr size_t WS_WABS = WS_WDT + (size_t)16 * 2048 * 512 * 2;
constexpr size_t WS_WUVP = WS_WABS + (size_t)3 * 512 * 256 * 2;
constexpr size_t WS_EID = WS_WUVP + (size_t)3 * 256 * 512 * 2;
constexpr size_t WS_GW = WS_EID + (size_t)SEQ * 2 * 4;
constexpr size_t WS_SLOT = WS_GW + (size_t)SEQ * 2 * 4;
constexpr int XS_ROWS = 20480;
constexpr size_t WS_SGW = WS_SLOT + (size_t)SEQ * 2 * 4;
constexpr size_t WS_YCAT = WS_SGW + (size_t)XS_ROWS * 4;
constexpr size_t WS_R = WS_YCAT + (size_t)SEQ * 2048 * 2;
constexpr size_t WS_QSB = WS_R;
constexpr size_t WS_KSB = WS_QSB + (size_t)SEQ * 768 * 2;
constexpr size_t WS_VT = WS_KSB + (size_t)SEQ * 768 * 2;
constexpr size_t WS_QR = WS_VT + (size_t)SEQ * 768 * 2;
constexpr size_t WS_KR = WS_QR + (size_t)SEQ * 512 * 2;
constexpr size_t WS_VR = WS_KR + (size_t)SEQ * 512 * 2;
constexpr size_t WS_GR = WS_VR + (size_t)SEQ * 512 * 2;
constexpr size_t WS_QD = WS_GR + (size_t)SEQ * 512 * 2;
constexpr size_t WS_CKV = WS_QD + (size_t)SEQ * 768 * 2;
constexpr size_t WS_QI = WS_CKV + (size_t)SEQ * 256 * 2;
constexpr size_t WS_KW = WS_QI + (size_t)SEQ * 512 * 2;
constexpr size_t WS_CN = WS_KW + (size_t)SEQ * 256 * 2;
constexpr size_t WS_QP = WS_CN + (size_t)SEQ * 256 * 2;
constexpr size_t WS_KVT = WS_QP + (size_t)SEQ * 1536 * 2;
constexpr size_t WS_ST = WS_KVT + (size_t)4 * 64 * 128 * 128 * 4;
constexpr size_t WS_OP = WS_ST + (size_t)4 * 64 * 128 * 128 * 2;
constexpr size_t WS_SC = WS_OP + (size_t)SEQ * 1536 * 2;
constexpr size_t SC_ELEMS = (size_t)16 * 2048 * 2049 / 2;
constexpr size_t WS_END_ATT = WS_SC + SC_ELEMS * 4;
constexpr size_t WS_X1 = WS_R;
constexpr size_t WS_XS = WS_X1 + (size_t)SEQ * 2048 * 4;
constexpr size_t WS_ACT = WS_XS + (size_t)XS_ROWS * 2048 * 2;
constexpr size_t WS_DN = WS_ACT + (size_t)XS_ROWS * 512 * 2;
constexpr size_t WS_END_FFN = WS_DN + (size_t)XS_ROWS * 2048 * 2;
constexpr size_t WS_END = WS_END_ATT > WS_END_FFN ? WS_END_ATT : WS_END_FFN;
static_assert(WS_END <= (size_t)604313600, "workspace over the guaranteed minimum");
__host__ __device__ __forceinline__ size_t sc_rowoff(int t) { const size_t a = (size_t)(t >> 2), b = (size_t)(t & 3); return 4 * (a + 1) * (2 * a + b); }
constexpr int CW_BAR = 0;
constexpr int CW_NT = 4096;
constexpr int CW_TEXP = 4160;
constexpr int CW_BCNT = 4352;
constexpr int CW_SLOT = 8448;

struct Params {
    const float* x; const float* w_in; const float* w_kv_up; const float* kv_norm_g; const float* ret_gn_g;
    const float* w_o; const float* ln1_g; const float* ln1_b; const float* w_router;
    const float* w_gate; const float* w_up; const float* w_down; const float* ln2_g; const float* ln2_b;
    float* out; unsigned char* ws; int ph_lo, ph_hi;
};

__device__ __forceinline__ unsigned cvt_pk_bf16(float lo, float hi) { unsigned r; asm("v_cvt_pk_bf16_f32 %0, %1, %2" : "=v"(r) : "v"(lo), "v"(hi)); return r; }
__device__ __forceinline__ float bflo(unsigned u) { return __uint_as_float(u << 16); }
__device__ __forceinline__ float bfhi(unsigned u) { return __uint_as_float(u & 0xffff0000u); }
__device__ __forceinline__ float wave_sum(float v) {
#pragma unroll
    for (int m = 32; m >= 1; m >>= 1) v += __shfl_xor(v, m);
    return v;
}
__device__ __forceinline__ f32x16 mfma32(bf16x8 a, bf16x8 b, f32x16 c) { return __builtin_amdgcn_mfma_f32_32x32x16_bf16(a, b, c, 0, 0, 0); }
__device__ __forceinline__ f32x4 mfma16(bf16x8 a, bf16x8 b, f32x4 c) { return __builtin_amdgcn_mfma_f32_16x16x32_bf16(a, b, c, 0, 0, 0); }
__device__ __forceinline__ bf16x8 as_bf16x8(u32x4 v) { return __builtin_bit_cast(bf16x8, v); }

#define XB_TMO      128
#define XB_XCNT(j)  (256  + 64 * (j))
#define XB_XSUB(j)  (1280 + 64 * (j))
#define XB_XGEN(j)  (2304 + 64 * (j))
#define XB_TOP      3328
#define XB_TOPGEN   3392
#define XCD_BAR_WORDS 3456
#define XB_SPIN_CAP (1u << 22)
__device__ __forceinline__ unsigned xb_ld(unsigned* p)              { return __hip_atomic_load(p, __ATOMIC_RELAXED, __HIP_MEMORY_SCOPE_AGENT); }
__device__ __forceinline__ unsigned xb_add(unsigned* p, unsigned v) { return __hip_atomic_fetch_add(p, v, __ATOMIC_RELAXED, __HIP_MEMORY_SCOPE_AGENT); }
__device__ __forceinline__ unsigned xb_xcc_id() { return (unsigned)__builtin_amdgcn_s_getreg((3 << 11) | 20) & 0xFu; }
#define XB_SPIN(cond, bar) do { unsigned _sp = 0; while (cond) { __builtin_amdgcn_s_sleep(1); \
    if ((++_sp & 255u) == 0u) { if (xb_ld(&(bar)[XB_TMO])) break; if (_sp > XB_SPIN_CAP) { atomicAdd(&(bar)[XB_TMO], 1u); break; } } } } while (0)
struct XcdBarrier { unsigned* bar; unsigned x; volatile LAS unsigned* st; };
__device__ __forceinline__ XcdBarrier xcd_barrier_post(unsigned* bar, volatile LAS unsigned* st) {
    XcdBarrier b; b.bar = bar; b.x = xb_xcc_id(); b.st = st;
    if (threadIdx.x == 0) (void)xb_add(&bar[XB_XCNT(b.x)], 1u);
    return b;
}
__device__ __forceinline__ void xcd_barrier_complete(unsigned* bar, unsigned x, unsigned& nloc, unsigned& nx) {
    const unsigned G = gridDim.x * gridDim.y * gridDim.z;
    unsigned sum, cnt, mine, sp = 0u;
    for (;;) {
        sum = 0u; cnt = 0u; mine = 0u;
#pragma unroll
        for (unsigned j = 0; j < 16; ++j) { const unsigned c = xb_ld(&bar[XB_XCNT(j)]); sum += c; cnt += (c > 0u) ? 1u : 0u; mine = (j == x) ? c : mine; }
        if (sum == G) break;
        __builtin_amdgcn_s_sleep(1);
        if ((++sp & 255u) == 0u) { if (xb_ld(&bar[XB_TMO])) break; if (sp > XB_SPIN_CAP) { atomicAdd(&bar[XB_TMO], 1u); break; } }
    }
    nloc = mine > 0u ? mine : 1u; nx = cnt > 0u ? cnt : 1u;
}
__device__ __forceinline__ void xcd_barrier(const XcdBarrier& b) {
    asm volatile("s_waitcnt vmcnt(0)" ::: "memory");
    __syncthreads();
    if (threadIdx.x == 0) {
        unsigned* bar = b.bar;
        __builtin_amdgcn_s_waitcnt(0);
        unsigned nloc = b.st[0], nx = b.st[1];
        if (nloc == 0u) { xcd_barrier_complete(bar, b.x, nloc, nx); b.st[0] = nloc; b.st[1] = nx; }
        const unsigned old = xb_add(&bar[XB_XSUB(b.x)], 1u);
        const unsigned gen = old / nloc;
        if (old + 1u == (gen + 1u) * nloc) {
            __builtin_amdgcn_fence(__ATOMIC_RELEASE, "agent");
            asm volatile("s_waitcnt vmcnt(0)" ::: "memory");
            const unsigned og = xb_add(&bar[XB_TOP], 1u);
            const unsigned tg = og / nx;
            if (og + 1u == (tg + 1u) * nx) xb_add(&bar[XB_TOPGEN], 1u);
            else XB_SPIN(xb_ld(&bar[XB_TOPGEN]) == tg, bar);
            __builtin_amdgcn_fence(__ATOMIC_ACQUIRE, "agent");
            xb_add(&bar[XB_XGEN(b.x)], 1u);
            asm volatile("s_waitcnt vmcnt(0)" ::: "memory");
        } else {
            XB_SPIN(xb_ld(&bar[XB_XGEN(b.x)]) == gen, bar);
            __builtin_amdgcn_fence(__ATOMIC_ACQUIRE, "agent");
            asm volatile("s_waitcnt vmcnt(0)" ::: "memory");
        }
    }
    __syncthreads();
}

namespace pg8 {
constexpr int BM = 256, BK = 64, HALF = 128, HTB = HALF * BK * 2, STAGE_BYTES = 8 * HTB;
__device__ __forceinline__ void stage_rc(int b, int& R, int& C) { const int st = b / 1024, sb = b % 1024, swz = sb ^ (((sb >> 9) & 1) << 5); R = (st >> 1) * 16 + swz / 64; C = (st & 1) * 32 + (swz % 64) / 2; }
__device__ __forceinline__ int lds_byte(int r, int c) { const int st = (r >> 4) * 2 + (c >> 5), rr = r & 15, cc = c & 31, ob = rr * 64 + cc * 2; return st * 1024 + (ob ^ (((ob >> 9) & 1) << 5)); }
__device__ __forceinline__ int perm32(int rho) { const int n = rho >> 4, i = rho & 15; return 8 * (i >> 2) + 4 * n + (i & 3); }
struct Unit { int pm, pn, kind; const char* pa; const char* pb; };
struct Dims { int K, lda, ldb; };

template <class Epi, class Sched>
__device__ __forceinline__ void gemm_phase(LAS unsigned char* lds, const Dims g, const Sched& S, const Epi& E, const int tid) {
    const int wid = __builtin_amdgcn_readfirstlane(tid >> 6), lane = tid & 63, wr = wid >> 2, wc = wid & 3, fr = lane & 15, fq = lane >> 4;
    const int K = g.K, nt = K / BK;
    unsigned voffA[2], voffB[2];
#pragma unroll
    for (int i = 0; i < 2; ++i) { int R, C; stage_rc(tid * 16 + i * 8192, R, C); const int Rb = (R & ~31) + perm32(R & 31);
        voffA[i] = (unsigned)(R * g.lda + C) * 2u; voffB[i] = (unsigned)(Rb * g.ldb + C) * 2u; }
    const size_t kstep = (size_t)(BK * 2);
    const size_t hstepA = (size_t)HALF * g.lda * 2, hstepB = (size_t)HALF * g.ldb * 2;
    const unsigned ldsw = (unsigned)wid * 1024u;
    const int aoff = lds_byte(wr * 64 + fr, fq * 8), boff = lds_byte(wc * 32 + fr, fq * 8);
#define PG8_SA(b, h) (((b) * 2 + (h)) * HTB)
#define PG8_SB(b, h) ((4 + (b) * 2 + (h)) * HTB)
#define PG8_STAGE(bufoff, gbase, voff) do { _Pragma("unroll") for (int _i = 0; _i < 2; ++_i) \
        __builtin_amdgcn_global_load_lds((const unsigned*)((const char*)(gbase) + (voff)[_i]), (LAS unsigned*)(lds + (bufoff) + ldsw + _i * 8192), 16, 0, 0); } while (0)
#define PG8_LDA(dst, b, h) do { _Pragma("unroll") for (int m = 0; m < 4; ++m) _Pragma("unroll") for (int k = 0; k < 2; ++k) dst[m][k] = *(const LAS bf16x8*)(lds + PG8_SA(b, h) + aoff + m * 2048 + k * 1024); } while (0)
#define PG8_LDB(dst, b, h) do { _Pragma("unroll") for (int n = 0; n < 2; ++n) _Pragma("unroll") for (int k = 0; k < 2; ++k) dst[n][k] = *(const LAS bf16x8*)(lds + PG8_SB(b, h) + boff + n * 2048 + k * 1024); } while (0)
#define PG8_MMA(ai, bj, At, Bt) do { __builtin_amdgcn_s_setprio(1); _Pragma("unroll") for (int m = 0; m < 4; ++m) _Pragma("unroll") for (int n = 0; n < 2; ++n) _Pragma("unroll") for (int k = 0; k < 2; ++k) \
        acc[ai][bj][m][n] = __builtin_amdgcn_mfma_f32_16x16x32_bf16(Bt[n][k], At[m][k], acc[ai][bj][m][n], 0, 0, 0); __builtin_amdgcn_s_setprio(0); } while (0)
#define PG8_WAIT_V(n) asm volatile("s_waitcnt vmcnt(" #n ")" ::: "memory")
#define PG8_WAIT_L(n) asm volatile("s_waitcnt lgkmcnt(" #n ")" ::: "memory")
#define PG8_BAR __builtin_amdgcn_s_barrier()
#define PG8_SCHED __builtin_amdgcn_sched_barrier(0)
    Unit cur, nxt; int ui = 0;
    if (!S.next(0, cur)) return;
    f32x4 acc[2][2][4][2];
#pragma unroll
    for (int a = 0; a < 2; ++a)
#pragma unroll
        for (int b = 0; b < 2; ++b)
#pragma unroll
            for (int m = 0; m < 4; ++m)
#pragma unroll
                for (int n = 0; n < 2; ++n) acc[a][b][m][n] = (f32x4){0.f, 0.f, 0.f, 0.f};
    bf16x8 At[4][2], B0[2][2], B1[2][2];
    const char* cA = cur.pa; const char* cB = cur.pb;
    PG8_STAGE(PG8_SB(0, 0), cB, voffB); PG8_STAGE(PG8_SA(0, 0), cA, voffA); PG8_STAGE(PG8_SB(0, 1), cB + hstepB, voffB); PG8_STAGE(PG8_SA(0, 1), cA + hstepA, voffA);
    if (wr == 1) PG8_BAR;
    PG8_WAIT_V(4); PG8_BAR;
    PG8_STAGE(PG8_SB(1, 0), cB + kstep, voffB); PG8_STAGE(PG8_SA(1, 0), cA + kstep, voffA); PG8_STAGE(PG8_SB(1, 1), cB + hstepB + kstep, voffB);
    PG8_WAIT_V(6); PG8_BAR;
    for (;;) {
        const bool has_next = S.next(ui + 1, nxt);
        const char* nA = has_next ? nxt.pa : cA; const char* nB = has_next ? nxt.pb : cB;
        for (int t = 0; t < nt; t += 2) {
            const bool last = (t == nt - 2);
            const char* a1 = cA + (size_t)(t + 1) * kstep;
            const char* a2 = last ? nA : cA + (size_t)(t + 2) * kstep; const char* b2 = last ? nB : cB + (size_t)(t + 2) * kstep;
            const char* a3 = a2 + kstep; const char* b3 = b2 + kstep;
            PG8_LDB(B0, 0, 0); PG8_SCHED; PG8_LDA(At, 0, 0); PG8_STAGE(PG8_SA(1, 1), a1 + hstepA, voffA);
            PG8_WAIT_L(8); PG8_BAR; PG8_WAIT_L(0); PG8_MMA(0, 0, At, B0); PG8_BAR; PG8_SCHED;
            PG8_LDB(B1, 0, 1); PG8_STAGE(PG8_SB(0, 0), b2, voffB);
            PG8_BAR; PG8_WAIT_L(0); PG8_MMA(0, 1, At, B1); PG8_BAR;
            PG8_LDA(At, 0, 1); PG8_STAGE(PG8_SA(0, 0), a2, voffA);
            PG8_BAR; PG8_WAIT_L(0); PG8_MMA(1, 0, At, B0); PG8_BAR; PG8_SCHED;
            PG8_STAGE(PG8_SB(0, 1), b2 + hstepB, voffB);
            PG8_WAIT_V(6); PG8_BAR; PG8_MMA(1, 1, At, B1); PG8_BAR;
            PG8_LDB(B0, 1, 0); PG8_SCHED; PG8_LDA(At, 1, 0); PG8_STAGE(PG8_SA(0, 1), a2 + hstepA, voffA);
            PG8_WAIT_L(8); PG8_BAR; PG8_WAIT_L(0); PG8_MMA(0, 0, At, B0); PG8_BAR; PG8_SCHED;
            PG8_LDB(B1, 1, 1); PG8_STAGE(PG8_SB(1, 0), b3, voffB);
            PG8_BAR; PG8_WAIT_L(0); PG8_MMA(0, 1, At, B1); PG8_BAR;
            PG8_LDA(At, 1, 1); PG8_STAGE(PG8_SA(1, 0), a3, voffA);
            PG8_BAR; PG8_WAIT_L(0); PG8_MMA(1, 0, At, B0); PG8_BAR; PG8_SCHED;
            PG8_STAGE(PG8_SB(1, 1), b3 + hstepB, voffB);
            PG8_WAIT_V(6); PG8_BAR; PG8_MMA(1, 1, At, B1); PG8_BAR;
        }
        E(acc, cur, wr, wc, fr, fq);
        if (!has_next) break;
#pragma unroll
        for (int a = 0; a < 2; ++a)
#pragma unroll
            for (int b = 0; b < 2; ++b)
#pragma unroll
                for (int m = 0; m < 4; ++m)
#pragma unroll
                    for (int n = 0; n < 2; ++n) acc[a][b][m][n] = (f32x4){0.f, 0.f, 0.f, 0.f};
        cur = nxt; cA = nA; cB = nB; ++ui;
    }
    PG8_WAIT_V(0);
    if (wr == 0) PG8_BAR;
    PG8_BAR;
#undef PG8_SA
#undef PG8_SB
#undef PG8_STAGE
#undef PG8_LDA
#undef PG8_LDB
#undef PG8_MMA
#undef PG8_WAIT_V
#undef PG8_WAIT_L
#undef PG8_BAR
#undef PG8_SCHED
}
typedef f32x4 Acc[2][2][4][2];
__device__ __forceinline__ void store_bf16_tile(const Acc& acc, bf16_t* base, int ldc, float scale, int wr, int wc, int fr, int fq) {
#pragma unroll
    for (int ai = 0; ai < 2; ++ai)
#pragma unroll
        for (int m = 0; m < 4; ++m) {
            bf16_t* rowp = base + (size_t)(ai * HALF + wr * 64 + m * 16 + fr) * ldc + wc * 32 + 8 * fq;
#pragma unroll
            for (int bj = 0; bj < 2; ++bj) {
                const f32x4 v0 = acc[ai][bj][m][0] * scale, v1 = acc[ai][bj][m][1] * scale;
                u32x4 w; w.x = cvt_pk_bf16(v0[0], v0[1]); w.y = cvt_pk_bf16(v0[2], v0[3]); w.z = cvt_pk_bf16(v1[0], v1[1]); w.w = cvt_pk_bf16(v1[2], v1[3]);
                *(u32x4*)(rowp + bj * HALF) = w;
            }
        }
}
}

constexpr size_t TS2048 = (size_t)256 * 2048 * 2;
struct ProjSched {
    const char* Z; int G, c;
    __device__ bool next(int i, pg8::Unit& u) const {
        const int L = i * G + c; if (L >= 768) return false;
        if (L < 672) { u.pm = L / 21; u.pn = L % 21; u.kind = 0; u.pa = Z + (size_t)u.pm * TS2048; u.pb = Z + (size_t)(32 + u.pn) * TS2048; }
        else { const int L2 = L - 672; u.pm = 21 + L2 / 32; u.pn = L2 % 32; u.kind = 1; u.pa = Z + (size_t)(32 + u.pm) * TS2048; u.pb = Z + (size_t)u.pn * TS2048; }
        return true;
    }
};
struct ProjEpi {
    unsigned char* ws;
    __device__ __forceinline__ void operator()(const pg8::Acc& acc, const pg8::Unit& u, int wr, int wc, int fr, int fq) const {
        if (u.kind == 0) {
            const int j = u.pn; const size_t r0 = (size_t)u.pm * 256;
            {
                size_t off; int ld, ct; float sc = 1.0f;
                if (j < 3)       { off = WS_QSB; ld = 768; ct = j; sc = SB_QSCALE; }
                else if (j < 6)  { off = WS_KSB; ld = 768; ct = j - 3; }
                else if (j < 8)  { off = WS_QR; ld = 512; ct = j - 6; }
                else if (j < 10) { off = WS_KR; ld = 512; ct = j - 8; }
                else if (j < 12) { off = WS_VR; ld = 512; ct = j - 10; }
                else if (j < 14) { off = WS_GR; ld = 512; ct = j - 12; }
                else if (j < 17) { off = WS_QD; ld = 768; ct = j - 14; }
                else if (j < 18) { off = WS_CKV; ld = 256; ct = 0; }
                else if (j < 20) { off = WS_QI; ld = 512; ct = j - 18; }
                else             { off = WS_KW; ld = 256; ct = 0; }
                pg8::store_bf16_tile(acc, (bf16_t*)(ws + off) + r0 * ld + ct * 256, ld, sc, wr, wc, fr, fq);
            }
        } else {
            bf16_t* base = (bf16_t*)(ws + WS_VT) + (size_t)(u.pm - 21) * 256 * SEQ + (size_t)u.pn * 256;
#pragma unroll
            for (int ai = 0; ai < 2; ++ai)
#pragma unroll
                for (int m = 0; m < 4; ++m) { bf16_t* rowp = base + (size_t)(ai * 128 + wr * 64 + m * 16 + fr) * SEQ + wc * 32 + 16 * (fq >> 1) + 4 * (fq & 1);
#pragma unroll
                    for (int bj = 0; bj < 2; ++bj) { const f32x4 v0 = acc[ai][bj][m][0], v1 = acc[ai][bj][m][1];
                        u32x2 w0, w1; w0.x = cvt_pk_bf16(v0[0], v0[1]); w0.y = cvt_pk_bf16(v0[2], v0[3]); w1.x = cvt_pk_bf16(v1[0], v1[1]); w1.y = cvt_pk_bf16(v1[2], v1[3]);
                        *(u32x2*)(rowp + bj * 128) = w0; *(u32x2*)(rowp + bj * 128 + 8) = w1; } }
        }
    }
};
struct GridSched {
    const char* A; const char* B; int nM, nN, nP; size_t aTile, bTile, aBatch, bBatch; int G, c;
    __device__ bool next(int i, pg8::Unit& u) const {
        const int L = i * G + c; if (L >= nM * nN * nP) return false;
        const int p = L / (nM * nN), r = L % (nM * nN); u.pm = r / nN; u.pn = r % nN; u.kind = p;
        u.pa = A + (size_t)p * aBatch + (size_t)u.pm * aTile; u.pb = B + (size_t)p * bBatch + (size_t)u.pn * bTile; return true;
    }
};
struct Bf16Epi {
    bf16_t* O; int ldc, batchCols; float scale;
    __device__ __forceinline__ void operator()(const pg8::Acc& acc, const pg8::Unit& u, int wr, int wc, int fr, int fq) const {
        pg8::store_bf16_tile(acc, O + (size_t)u.pm * 256 * ldc + u.kind * batchCols + u.pn * 256, ldc, scale, wr, wc, fr, fq);
    }
};
struct ResF32Epi {
    float* H; const float* res;
    __device__ __forceinline__ void operator()(const pg8::Acc& acc, const pg8::Unit& u, int wr, int wc, int fr, int fq) const {
#pragma unroll
        for (int ai = 0; ai < 2; ++ai)
#pragma unroll
            for (int m = 0; m < 4; ++m) { const size_t o = (size_t)(u.pm * 256 + ai * 128 + wr * 64 + m * 16 + fr) * 2048 + u.pn * 256 + wc * 32 + 8 * fq;
#pragma unroll
                for (int bj = 0; bj < 2; ++bj) {
                    const f32x4 r0 = *(const f32x4*)(res + o + bj * 128), r1 = *(const f32x4*)(res + o + bj * 128 + 4);
                    *(f32x4*)(H + o + bj * 128) = r0 * ALPHA + acc[ai][bj][m][0]; *(f32x4*)(H + o + bj * 128 + 4) = r1 * ALPHA + acc[ai][bj][m][1]; } }
    }
};
struct MoeSched {
    const char* A; const char* B; const unsigned* ctl; int nN; size_t aTile, bTile; int G, c;
    __device__ bool next(int i, pg8::Unit& u) const {
        const int nt = (int)__hip_atomic_load(ctl + CW_NT, __ATOMIC_RELAXED, __HIP_MEMORY_SCOPE_AGENT); const int L = i * G + c; if (L >= nt * nN) return false;
        u.pm = L / nN; u.pn = L % nN; u.kind = (int)__hip_atomic_load(ctl + CW_TEXP + u.pm, __ATOMIC_RELAXED, __HIP_MEMORY_SCOPE_AGENT);
        u.pa = A + (size_t)u.pm * aTile; u.pb = B + (size_t)(u.kind * nN + u.pn) * bTile; return true;
    }
};
struct GateUpEpi {
    bf16_t* act; const float* sgw;
    __device__ __forceinline__ void operator()(const pg8::Acc& acc, const pg8::Unit& u, int wr, int wc, int fr, int fq) const {
#pragma unroll
        for (int ai = 0; ai < 2; ++ai)
#pragma unroll
            for (int m = 0; m < 4; ++m) { const int slot = u.pm * 256 + ai * 128 + wr * 64 + m * 16 + fr; const float gw = sgw[slot];
                float o[8];
#pragma unroll
                for (int n = 0; n < 2; ++n)
#pragma unroll
                    for (int e = 0; e < 4; ++e) { const float gt = acc[ai][0][m][n][e], up = acc[ai][1][m][n][e];
                        o[n * 4 + e] = gt / (1.0f + __expf(-gt)) * up * gw; }
                u32x4 w; w.x = cvt_pk_bf16(o[0], o[1]); w.y = cvt_pk_bf16(o[2], o[3]); w.z = cvt_pk_bf16(o[4], o[5]); w.w = cvt_pk_bf16(o[6], o[7]);
                *(u32x4*)(act + (size_t)slot * 512 + u.pn * 128 + wc * 32 + 8 * fq) = w; }
    }
};
struct DownEpi {
    bf16_t* dn;
    __device__ __forceinline__ void operator()(const pg8::Acc& acc, const pg8::Unit& u, int wr, int wc, int fr, int fq) const {
        pg8::store_bf16_tile(acc, dn + (size_t)u.pm * 256 * 2048 + u.pn * 256, 2048, 1.0f, wr, wc, fr, fq);
    }
};

__device__ __forceinline__ void cvt_T(LAS float* tile, const float* src, int ldsrc, int col0, int ncols, int K, bf16_t* dst, int& tbase, int bid, int nb, int tid) {
    const int ntk = K >> 6, ntn = (ncols + 63) >> 6, count = ntk * ntn;
    int g = tbase + (((bid - tbase) % nb) + nb) % nb;
    const int gend = tbase + count; tbase = gend;
    float v[8];
    if (g < gend) { const int t = g - (gend - count), tn = t / ntk, tk = t % ntk;
#pragma unroll
        for (int i = 0; i < 8; ++i) { const int idx = tid + NTHR * i, kk = idx >> 6, n = tn * 64 + (idx & 63);
            v[i] = (n < ncols) ? src[(size_t)(tk * 64 + kk) * ldsrc + col0 + n] : 0.f; } }
    for (; g < gend; g += nb) {
        const int t = g - (gend - count), tn = t / ntk, tk = t % ntk;
#pragma unroll
        for (int i = 0; i < 8; ++i) { const int idx = tid + NTHR * i; tile[(idx >> 6) * 65 + (idx & 63)] = v[i]; }
        __syncthreads();
        if (g + nb < gend) { const int t2 = g + nb - (gend - count), tn2 = t2 / ntk, tk2 = t2 % ntk;
#pragma unroll
            for (int i = 0; i < 8; ++i) { const int idx = tid + NTHR * i, kk = idx >> 6, n = tn2 * 64 + (idx & 63);
                v[i] = (n < ncols) ? src[(size_t)(tk2 * 64 + kk) * ldsrc + col0 + n] : 0.f; } }
#pragma unroll
        for (int i = 0; i < 4; ++i) { const int p = tid + NTHR * i, nn = p >> 5, kp = p & 31, n = tn * 64 + nn;
            if (n < ncols) *(unsigned*)(dst + (size_t)n * K + tk * 64 + 2 * kp) = cvt_pk_bf16(tile[(2 * kp) * 65 + nn], tile[(2 * kp + 1) * 65 + nn]); }
        __syncthreads();
    }
}
__device__ __forceinline__ void p0_common(const Params& P, unsigned char* ws, int bid, int nb, int tid) {
    const int gtid = bid * NTHR + tid, gn = nb * NTHR;
    { bf16_t* xb = (bf16_t*)(ws + WS_Z);
      for (size_t i = gtid; i < (size_t)SEQ * DM / 8; i += gn) { const f32x4 a = *(const f32x4*)(P.x + i * 8), b = *(const f32x4*)(P.x + i * 8 + 4);
          u32x4 w; w.x = cvt_pk_bf16(a[0], a[1]); w.y = cvt_pk_bf16(a[2], a[3]); w.z = cvt_pk_bf16(b[0], b[1]); w.w = cvt_pk_bf16(b[2], b[3]); *(u32x4*)(xb + i * 8) = w; } }
    { f32x2* rot = (f32x2*)(ws + WS_ROT);
      for (int i = gtid; i < SEQ * 64; i += gn) { const int t = i >> 6, f = i & 63;
          const float theta = exp2f(-((float)f / 63.0f) * 13.287712379549449f); const float ang = (float)t * theta;
          double r = (double)ang * 0.15915494309189535; r -= floor(r); const float rf = (float)r;
          rot[i] = (f32x2){__builtin_amdgcn_cosf(rf), __builtin_amdgcn_sinf(rf)}; } }
}
__device__ __forceinline__ void p0_weights(const Params& P, unsigned char* ws, LAS unsigned char* lds, int l, int bid, int nb, int tid) {
    LAS float* tile = (LAS float*)lds;
    const int gtid = bid * NTHR + tid, gn = nb * NTHR;
    {
        const float* wkv = P.w_kv_up + (size_t)l * 256 * 1536;
        bf16_t* wabs = (bf16_t*)(ws + WS_WABS); bf16_t* wuvp = (bf16_t*)(ws + WS_WUVP);
        for (int i = gtid; i < 3 * 512 * 256; i += gn) { const int k = i & 255, row = (i >> 8) & 511, p = i >> 17, hh = row >> 8, r = row & 255;
            const float v = ((k >> 7) == hh) ? wkv[(size_t)r * 1536 + (2 * p + hh) * 256 + (k & 127)] : 0.f; wabs[i] = (bf16_t)(cvt_pk_bf16(v, 0.f) & 0xffffu); }
        for (int i = gtid; i < 3 * 256 * 512; i += gn) { const int k = i & 511, row = (i >> 9) & 255, p = i >> 17, hh = row >> 7, e = row & 127;
            const float v = ((k >> 8) == hh) ? wkv[(size_t)(k & 255) * 1536 + (2 * p + hh) * 256 + 128 + e] : 0.f; wuvp[i] = (bf16_t)(cvt_pk_bf16(v, 0.f) & 0xffffu); }
        { bf16_t* wt = (bf16_t*)(ws + WS_Z) + (size_t)8192 * 2048;
          for (int i = gtid; i < 184 * 2048 / 8; i += gn) *(u32x4*)(wt + (size_t)5192 * 2048 + (size_t)i * 8) = (u32x4){0u, 0u, 0u, 0u}; }
    }
    int tb = 0;
    {
        bf16_t* wt = (bf16_t*)(ws + WS_Z) + (size_t)8192 * 2048;
        const float* win = P.w_in + (size_t)l * 2048 * DIN;
        cvt_T(tile, win, DIN, 0, 1536, 2048, wt, tb, bid, nb, tid);
        cvt_T(tile, win, DIN, 2304, 3656, 2048, wt + (size_t)1536 * 2048, tb, bid, nb, tid);
        cvt_T(tile, win, DIN, 1536, 768, 2048, wt + (size_t)5376 * 2048, tb, bid, nb, tid);
        cvt_T(tile, P.w_o + (size_t)l * 2048 * 2048, 2048, 0, 2048, 2048, (bf16_t*)(ws + WS_WOT), tb, bid, nb, tid);
        for (int e = 0; e < 16; ++e) {
            const float* wg = P.w_gate + ((size_t)l * 16 + e) * 2048 * 512; const float* wu = P.w_up + ((size_t)l * 16 + e) * 2048 * 512;
            bf16_t* d = (bf16_t*)(ws + WS_WGU) + (size_t)e * 1024 * 2048;
            for (int pn = 0; pn < 4; ++pn) {
                cvt_T(tile, wg, 512, pn * 128, 128, 2048, d + (size_t)(pn * 256) * 2048, tb, bid, nb, tid);
                cvt_T(tile, wu, 512, pn * 128, 128, 2048, d + (size_t)(pn * 256 + 128) * 2048, tb, bid, nb, tid);
            }
            cvt_T(tile, P.w_down + ((size_t)l * 16 + e) * 512 * 2048, 2048, 0, 2048, 512, (bf16_t*)(ws + WS_WDT) + (size_t)e * 2048 * 512, tb, bid, nb, tid);
        }
    }
}

constexpr int SB_KROW = 272, SB_VROW = 144;
constexpr int SB_KBUF = 64 * SB_KROW, SB_VBUF = 128 * SB_VROW;
__device__ __forceinline__ void sb_attn_phase(LAS unsigned char* lds, const bf16_t* __restrict__ Q, const bf16_t* __restrict__ Kg, const bf16_t* __restrict__ Vt, bf16_t* __restrict__ Y,
                              int ubase, int bid, int nb, int tid) {
    const int wid = __builtin_amdgcn_readfirstlane(tid >> 6), lane = tid & 63, ln = lane & 31, hl = lane >> 5;
    const int first = ubase + (((bid - ubase) % nb) + nb) % nb;
    for (int ug = first; ug < ubase + 192; ug += nb) {
        const int u = ug - ubase, qb = 31 - u / 6, h = u % 6;
        const int t0 = qb * 256, tw0 = t0 + 32 * wid, tq = tw0 + ln, twmax = tw0 + 31;
        const int nkt = 4 * qb + 4;
        bf16x8 bq[8];
#pragma unroll
        for (int s = 0; s < 8; ++s) bq[s] = *(const bf16x8*)(Q + (size_t)tq * 768 + h * 128 + 16 * s + 8 * hl);
        f32x16 O[4];
#pragma unroll
        for (int c = 0; c < 4; ++c)
#pragma unroll
            for (int i = 0; i < 16; ++i) O[c][i] = 0.f;
        float R = 0.f;
        u32x4 sk[2], sv[2];
        auto gload = [&](int kt) {
#pragma unroll
            for (int i = 0; i < 2; ++i) { const int c = tid + NTHR * i;
                sk[i] = *(const u32x4*)(Kg + (size_t)(kt * 64 + (c >> 4)) * 768 + h * 128 + (c & 15) * 8);
                sv[i] = *(const u32x4*)(Vt + (size_t)(h * 128 + (c >> 3)) * SEQ + kt * 64 + (c & 7) * 8); }
        };
        auto lstore = [&](int buf) {
#pragma unroll
            for (int i = 0; i < 2; ++i) { const int c = tid + NTHR * i;
                *(LAS u32x4*)(lds + buf * SB_KBUF + (c >> 4) * SB_KROW + (c & 15) * 16) = sk[i];
                *(LAS u32x4*)(lds + 2 * SB_KBUF + buf * SB_VBUF + (c >> 3) * SB_VROW + (c & 7) * 16) = sv[i]; }
        };
        gload(nkt - 1); lstore(0); __syncthreads();
        LAS int* flags = (LAS int*)(lds + 2 * SB_KBUF + 2 * SB_VBUF);
        for (int kt = nkt - 1; kt >= 0; --kt) {
            const int cur = (nkt - 1 - kt) & 1;
            if (kt > 0) gload(kt - 1);
            if (kt * 64 < twmax) {
                LAS unsigned char* kb = lds + cur * SB_KBUF; LAS unsigned char* vb = lds + 2 * SB_KBUF + cur * SB_VBUF;
#pragma unroll
                for (int uu = 1; uu >= 0; --uu) {
                    const int key0 = kt * 64 + 32 * uu;
                    if (key0 < twmax) {
                        f32x16 Sx;
#pragma unroll
                        for (int i = 0; i < 16; ++i) Sx[i] = 0.f;
#pragma unroll
                        for (int s = 0; s < 8; ++s) { const bf16x8 a = *(const LAS bf16x8*)(kb + (32 * uu + ln) * SB_KROW + (16 * s + 8 * hl) * 2); Sx = mfma32(a, bq[s], Sx); }
                        const bool need_mask = (key0 + 31 >= tw0);
                        float lr[16];
#pragma unroll
                        for (int i = 0; i < 16; ++i) {
                            float z = Sx[i];
                            if (need_mask) { const int key = key0 + (i & 3) + 8 * (i >> 2) + 4 * hl; z = (key < tq) ? z : -1e30f; }
                            const float sp = fmaxf(z, 0.f) + __builtin_amdgcn_logf(1.0f + __builtin_amdgcn_exp2f(-fabsf(z)));
                            lr[i] = -sp; Sx[i] = z;
                        }
                        float T[4], PT[4];
#pragma unroll
                        for (int g = 0; g < 4; ++g) { T[g] = (lr[4 * g] + lr[4 * g + 1]) + (lr[4 * g + 2] + lr[4 * g + 3]); PT[g] = __shfl_xor(T[g], 32); }
                        const float W0 = T[0] + PT[0], W1 = T[1] + PT[1], W2 = T[2] + PT[2], W3 = T[3] + PT[3];
                        float Ag[4]; Ag[3] = R; Ag[2] = R + W3; Ag[1] = Ag[2] + W2; Ag[0] = Ag[1] + W1;
                        R = Ag[0] + W0;
                        float pv[16];
#pragma unroll
                        for (int g = 0; g < 4; ++g) {
                            const float base = Ag[g] + (hl == 0 ? PT[g] : 0.f);
                            const float a3 = base, a2 = a3 + lr[4 * g + 3], a1 = a2 + lr[4 * g + 2], a0 = a1 + lr[4 * g + 1];
                            pv[4 * g + 3] = __builtin_amdgcn_exp2f(Sx[4 * g + 3] + lr[4 * g + 3] + a3);
                            pv[4 * g + 2] = __builtin_amdgcn_exp2f(Sx[4 * g + 2] + lr[4 * g + 2] + a2);
                            pv[4 * g + 1] = __builtin_amdgcn_exp2f(Sx[4 * g + 1] + lr[4 * g + 1] + a1);
                            pv[4 * g + 0] = __builtin_amdgcn_exp2f(Sx[4 * g + 0] + lr[4 * g + 0] + a0);
                        }
                        bf16x8 pb[2];
#pragma unroll
                        for (int s2 = 0; s2 < 2; ++s2) { u32x4 w; w.x = cvt_pk_bf16(pv[8 * s2], pv[8 * s2 + 1]); w.y = cvt_pk_bf16(pv[8 * s2 + 2], pv[8 * s2 + 3]);
                            w.z = cvt_pk_bf16(pv[8 * s2 + 4], pv[8 * s2 + 5]); w.w = cvt_pk_bf16(pv[8 * s2 + 6], pv[8 * s2 + 7]); pb[s2] = as_bf16x8(w); }
#pragma unroll
                        for (int c = 0; c < 4; ++c)
#pragma unroll
                            for (int s2 = 0; s2 < 2; ++s2) { const bf16x8 a = *(const LAS bf16x8*)(vb + (32 * c + ln) * SB_VROW + (32 * uu + 16 * s2 + 8 * hl) * 2); O[c] = mfma32(a, pb[s2], O[c]); }
                    }
                }
            }
            if (kt > 0) lstore(cur ^ 1);
            { const bool started = (kt * 64 < twmax); const int dn = (started && __all(R < -40.0f)) ? 1 : 0; if (lane == 0) flags[cur * 8 + wid] = dn; }
            __syncthreads();
            { int all = 1;
#pragma unroll
              for (int w = 0; w < 8; ++w) all &= flags[cur * 8 + w];
              if (all) break; }
        }
#pragma unroll
        for (int c = 0; c < 4; ++c)
#pragma unroll
            for (int g = 0; g < 4; ++g) { u32x2 w; w.x = cvt_pk_bf16(O[c][4 * g], O[c][4 * g + 1]); w.y = cvt_pk_bf16(O[c][4 * g + 2], O[c][4 * g + 3]);
                *(u32x2*)(Y + (size_t)tq * 2048 + h * 128 + 32 * c + 8 * g + 4 * hl) = w; }
    }
}

__constant__ float RET_L2G[4] = {-0.045803689613124735f, -0.022720076500083467f, -0.011315313227834146f, -0.0056465631411421125f};
constexpr int RT_ROW = 272;
constexpr int RT_TILE = 128 * RT_ROW;
__device__ __forceinline__ void rot8(const u32x4 a, const u32x4 b, const f32x2* __restrict__ cs, float sc, float (&o1)[8], float (&o2)[8]) {
#pragma unroll
    for (int j = 0; j < 4; ++j) {
        const float x1l = bflo(a[j]), x1h = bfhi(a[j]), x2l = bflo(b[j]), x2h = bfhi(b[j]);
        const f32x2 c0 = cs[2 * j], c1 = cs[2 * j + 1];
        o1[2 * j] = (x1l * c0.x - x2l * c0.y) * sc; o2[2 * j] = (x1l * c0.y + x2l * c0.x) * sc;
        o1[2 * j + 1] = (x1h * c1.x - x2h * c1.y) * sc; o2[2 * j + 1] = (x1h * c1.y + x2h * c1.x) * sc;
    }
}
__device__ __forceinline__ void ret_kv_phase(LAS unsigned char* lds, const bf16_t* __restrict__ Kr, const bf16_t* __restrict__ Vr, const f32x2* __restrict__ rot, float* __restrict__ KVT,
                             int ubase, int bid, int nb, int tid) {
    const int wid = __builtin_amdgcn_readfirstlane(tid >> 6), lane = tid & 63, ln = lane & 31, hl = lane >> 5;
    LAS unsigned char* vt = lds; LAS unsigned char* kt = lds + RT_TILE;
    const int first = ubase + (((bid - ubase) % nb) + nb) % nb;
    for (int ug = first; ug < ubase + 256; ug += nb) {
        const int u = ug - ubase, h = u >> 6, c = u & 63, j0 = c * 128;
        const float l2g = RET_L2G[h];
#pragma unroll
        for (int i = 0; i < 2; ++i) { const int it = tid + NTHR * i, j = it & 127, dg = it >> 7;
            const u32x4 a = *(const u32x4*)(Kr + (size_t)(j0 + j) * 512 + h * 128 + 8 * dg), b = *(const u32x4*)(Kr + (size_t)(j0 + j) * 512 + h * 128 + 64 + 8 * dg);
            float o1[8], o2[8]; rot8(a, b, rot + (size_t)(j0 + j) * 64 + 8 * dg, 0.08838834764831845f * __builtin_amdgcn_exp2f((float)(127 - j) * l2g), o1, o2);
#pragma unroll
            for (int e = 0; e < 8; e += 2) { const unsigned p1 = cvt_pk_bf16(o1[e], o1[e + 1]), p2 = cvt_pk_bf16(o2[e], o2[e + 1]);
                *(LAS bf16_t*)(kt + (8 * dg + e) * RT_ROW + j * 2) = (bf16_t)(p1 & 0xffffu); *(LAS bf16_t*)(kt + (8 * dg + e + 1) * RT_ROW + j * 2) = (bf16_t)(p1 >> 16);
                *(LAS bf16_t*)(kt + (64 + 8 * dg + e) * RT_ROW + j * 2) = (bf16_t)(p2 & 0xffffu); *(LAS bf16_t*)(kt + (64 + 8 * dg + e + 1) * RT_ROW + j * 2) = (bf16_t)(p2 >> 16); } }
#pragma unroll
        for (int i = 0; i < 4; ++i) { const int it = tid + NTHR * i, j = it & 127, ch = it >> 7;
            const u32x4 a = *(const u32x4*)(Vr + (size_t)(j0 + j) * 512 + h * 128 + 8 * ch);
#pragma unroll
            for (int e = 0; e < 4; ++e) { *(LAS bf16_t*)(vt + (8 * ch + 2 * e) * RT_ROW + j * 2) = (bf16_t)(a[e] & 0xffffu); *(LAS bf16_t*)(vt + (8 * ch + 2 * e + 1) * RT_ROW + j * 2) = (bf16_t)(a[e] >> 16); } }
        __syncthreads();
        const int ce = wid & 3, dh = wid >> 2;
        f32x16 acc[2];
#pragma unroll
        for (int n = 0; n < 2; ++n)
#pragma unroll
            for (int i = 0; i < 16; ++i) acc[n][i] = 0.f;
#pragma unroll
        for (int s = 0; s < 8; ++s) {
            const bf16x8 a = *(const LAS bf16x8*)(vt + (32 * ce + ln) * RT_ROW + (16 * s + 8 * hl) * 2);
#pragma unroll
            for (int n = 0; n < 2; ++n) { const bf16x8 b = *(const LAS bf16x8*)(kt + (64 * dh + 32 * n + ln) * RT_ROW + (16 * s + 8 * hl) * 2); acc[n] = mfma32(a, b, acc[n]); }
        }
        float* out = KVT + (size_t)u * 16384;
#pragma unroll
        for (int n = 0; n < 2; ++n)
#pragma unroll
            for (int i = 0; i < 16; ++i) out[(32 * ce + (i & 3) + 8 * (i >> 2) + 4 * hl) * 128 + 64 * dh + 32 * n + ln] = acc[n][i];
        __syncthreads();
    }
}
__device__ __forceinline__ void ret_scan_phase(const float* __restrict__ KVT, bf16_t* __restrict__ ST, int bid, int nb, int tid) {
    for (int idx = bid * NTHR + tid; idx < 65536; idx += nb * NTHR) {
        const int h = idx >> 14, ed = idx & 16383; const float cd = __builtin_amdgcn_exp2f(128.0f * RET_L2G[h]);
        float s = 0.f;
        for (int c0 = 0; c0 < 64; c0 += 8) {
            float kv[8];
#pragma unroll
            for (int k = 0; k < 8; ++k) kv[k] = KVT[((size_t)(h * 64 + c0 + k)) * 16384 + ed];
#pragma unroll
            for (int k = 0; k < 8; ++k) { ST[((size_t)(h * 64 + c0 + k)) * 16384 + ed] = (bf16_t)(cvt_pk_bf16(s, 0.f) & 0xffffu); s = s * cd + kv[k]; }
        }
    }
}
__device__ __forceinline__ void ret_out_phase(LAS unsigned char* lds, const bf16_t* __restrict__ Qr, const bf16_t* __restrict__ Kr, const bf16_t* __restrict__ Vr, const bf16_t* __restrict__ Gr,
                              const f32x2* __restrict__ rot, const bf16_t* __restrict__ ST, const float* __restrict__ gng, bf16_t* __restrict__ Y,
                              int ubase, int bid, int nb, int tid) {
    const int wid = __builtin_amdgcn_readfirstlane(tid >> 6), lane = tid & 63, ln = lane & 31, hl = lane >> 5;
    LAS unsigned char* kp = lds; LAS unsigned char* vt = lds + RT_TILE;
    const int first = ubase + (((bid - ubase) % nb) + nb) % nb;
    for (int ug = first; ug < ubase + 256; ug += nb) {
        const int u = ug - ubase, h = u >> 6, c = u & 63, j0 = c * 128;
        const float l2g = RET_L2G[h];
#pragma unroll
        for (int i = 0; i < 2; ++i) { const int it = tid + NTHR * i, dg = it & 7, j = it >> 3;
            const u32x4 a = *(const u32x4*)(Kr + (size_t)(j0 + j) * 512 + h * 128 + 8 * dg), b = *(const u32x4*)(Kr + (size_t)(j0 + j) * 512 + h * 128 + 64 + 8 * dg);
            float o1[8], o2[8]; rot8(a, b, rot + (size_t)(j0 + j) * 64 + 8 * dg, 0.08838834764831845f, o1, o2);
            u32x4 w1, w2; w1.x = cvt_pk_bf16(o1[0], o1[1]); w1.y = cvt_pk_bf16(o1[2], o1[3]); w1.z = cvt_pk_bf16(o1[4], o1[5]); w1.w = cvt_pk_bf16(o1[6], o1[7]);
            w2.x = cvt_pk_bf16(o2[0], o2[1]); w2.y = cvt_pk_bf16(o2[2], o2[3]); w2.z = cvt_pk_bf16(o2[4], o2[5]); w2.w = cvt_pk_bf16(o2[6], o2[7]);
            *(LAS u32x4*)(kp + j * RT_ROW + 16 * dg) = w1; *(LAS u32x4*)(kp + j * RT_ROW + 128 + 16 * dg) = w2; }
#pragma unroll
        for (int i = 0; i < 4; ++i) { const int it = tid + NTHR * i, j = it & 127, ch = it >> 7;
            const int pos = (j & ~15) | ((j & 3) + 4 * ((j >> 3) & 1) + 8 * ((j >> 2) & 1));
            const u32x4 a = *(const u32x4*)(Vr + (size_t)(j0 + j) * 512 + h * 128 + 8 * ch);
#pragma unroll
            for (int e = 0; e < 4; ++e) { *(LAS bf16_t*)(vt + (8 * ch + 2 * e) * RT_ROW + pos * 2) = (bf16_t)(a[e] & 0xffffu); *(LAS bf16_t*)(vt + (8 * ch + 2 * e + 1) * RT_ROW + pos * 2) = (bf16_t)(a[e] >> 16); } }
        __syncthreads();
        if (wid < 4) {
            const int il = 32 * wid + ln, tq = j0 + il;
            bf16x8 bq[8];
#pragma unroll
            for (int s = 0; s < 4; ++s) {
                const u32x4 a = *(const u32x4*)(Qr + (size_t)tq * 512 + h * 128 + 16 * s + 8 * hl), b = *(const u32x4*)(Qr + (size_t)tq * 512 + h * 128 + 64 + 16 * s + 8 * hl);
                float o1[8], o2[8]; rot8(a, b, rot + (size_t)tq * 64 + 16 * s + 8 * hl, 1.0f, o1, o2);
                u32x4 w1, w2; w1.x = cvt_pk_bf16(o1[0], o1[1]); w1.y = cvt_pk_bf16(o1[2], o1[3]); w1.z = cvt_pk_bf16(o1[4], o1[5]); w1.w = cvt_pk_bf16(o1[6], o1[7]);
                w2.x = cvt_pk_bf16(o2[0], o2[1]); w2.y = cvt_pk_bf16(o2[2], o2[3]); w2.z = cvt_pk_bf16(o2[4], o2[5]); w2.w = cvt_pk_bf16(o2[6], o2[7]);
                bq[s] = as_bf16x8(w1); bq[s + 4] = as_bf16x8(w2);
            }
            f32x16 O[4];
#pragma unroll
            for (int ce = 0; ce < 4; ++ce)
#pragma unroll
                for (int i = 0; i < 16; ++i) O[ce][i] = 0.f;
            const bf16_t* st = ST + (size_t)u * 16384;
#pragma unroll
            for (int ce = 0; ce < 4; ++ce)
#pragma unroll
                for (int s = 0; s < 8; ++s) { const bf16x8 a = *(const bf16x8*)(st + (size_t)(32 * ce + ln) * 128 + 16 * s + 8 * hl); O[ce] = mfma32(a, bq[s], O[ce]); }
            const float qd = __builtin_amdgcn_exp2f((float)(il + 1) * l2g);
#pragma unroll
            for (int ce = 0; ce < 4; ++ce)
#pragma unroll
                for (int i = 0; i < 16; ++i) O[ce][i] *= qd;
            for (int jb = 0; jb <= wid; ++jb) {
                f32x16 Sx;
#pragma unroll
                for (int i = 0; i < 16; ++i) Sx[i] = 0.f;
#pragma unroll
                for (int s = 0; s < 8; ++s) { const bf16x8 a = *(const LAS bf16x8*)(kp + (32 * jb + ln) * RT_ROW + (16 * s + 8 * hl) * 2); Sx = mfma32(a, bq[s], Sx); }
                float pv[16];
#pragma unroll
                for (int i = 0; i < 16; ++i) { const int jl = 32 * jb + (i & 3) + 8 * (i >> 2) + 4 * hl; const int diff = il - jl;
                    pv[i] = (diff >= 0) ? Sx[i] * __builtin_amdgcn_exp2f((float)diff * l2g) : 0.f; }
                bf16x8 pb[2];
#pragma unroll
                for (int s2 = 0; s2 < 2; ++s2) { u32x4 w; w.x = cvt_pk_bf16(pv[8 * s2], pv[8 * s2 + 1]); w.y = cvt_pk_bf16(pv[8 * s2 + 2], pv[8 * s2 + 3]);
                    w.z = cvt_pk_bf16(pv[8 * s2 + 4], pv[8 * s2 + 5]); w.w = cvt_pk_bf16(pv[8 * s2 + 6], pv[8 * s2 + 7]); pb[s2] = as_bf16x8(w); }
#pragma unroll
                for (int ce = 0; ce < 4; ++ce)
#pragma unroll
                    for (int s2 = 0; s2 < 2; ++s2) { const bf16x8 a = *(const LAS bf16x8*)(vt + (32 * ce + ln) * RT_ROW + (32 * jb + 16 * s2 + 8 * hl) * 2); O[ce] = mfma32(a, pb[s2], O[ce]); }
            }
            float sm = 0.f;
#pragma unroll
            for (int ce = 0; ce < 4; ++ce)
#pragma unroll
                for (int i = 0; i < 16; ++i) sm += O[ce][i];
            sm += __shfl_xor(sm, 32);
            const float mu = sm * (1.0f / 128.0f);
            float sq = 0.f;
#pragma unroll
            for (int ce = 0; ce < 4; ++ce)
#pragma unroll
                for (int i = 0; i < 16; ++i) { const float d = O[ce][i] - mu; sq += d * d; }
            sq += __shfl_xor(sq, 32);
            const float rstd = __builtin_amdgcn_rsqf(sq * (1.0f / 128.0f) + 1e-6f);
#pragma unroll
            for (int ce = 0; ce < 4; ++ce)
#pragma unroll
                for (int g = 0; g < 4; ++g) {
                    const int e0 = 32 * ce + 8 * g + 4 * hl;
                    const u32x2 gv = *(const u32x2*)(Gr + (size_t)tq * 512 + h * 128 + e0); const f32x4 gn = *(const f32x4*)(gng + h * 128 + e0);
                    float gg[4] = {bflo(gv.x), bfhi(gv.x), bflo(gv.y), bfhi(gv.y)}; float o[4];
#pragma unroll
                    for (int e = 0; e < 4; ++e) { const float y = (O[ce][4 * g + e] - mu) * rstd * gn[e]; o[e] = y * gg[e] / (1.0f + __expf(-gg[e])); }
                    u32x2 w; w.x = cvt_pk_bf16(o[0], o[1]); w.y = cvt_pk_bf16(o[2], o[3]);
                    *(u32x2*)(Y + (size_t)tq * 2048 + 768 + h * 128 + e0) = w;
                }
        }
        __syncthreads();
    }
}

__device__ __forceinline__ void cn_phase(const bf16_t* __restrict__ CKV, const float* __restrict__ g, bf16_t* __restrict__ CN, int bid, int nb, int tid) {
    const int wid = tid >> 6, lane = tid & 63;
    const f32x4 gv = *(const f32x4*)(g + 4 * lane);
    for (int t = bid * 8 + wid; t < SEQ; t += nb * 8) {
        const u32x2 vv = *(const u32x2*)(CKV + (size_t)t * 256 + 4 * lane); const f32x4 v = (f32x4){bflo(vv.x), bfhi(vv.x), bflo(vv.y), bfhi(vv.y)};
        const float ss = wave_sum(v[0] * v[0] + v[1] * v[1] + v[2] * v[2] + v[3] * v[3]);
        const float rs = __builtin_amdgcn_rsqf(ss * (1.0f / 256.0f) + 1e-6f);
        u32x2 w; w.x = cvt_pk_bf16(v[0] * rs * gv[0], v[1] * rs * gv[1]); w.y = cvt_pk_bf16(v[2] * rs * gv[2], v[3] * rs * gv[3]);
        *(u32x2*)(CN + (size_t)t * 256 + 4 * lane) = w;
    }
}
__device__ __forceinline__ void score_phase(const bf16_t* __restrict__ Qi, const bf16_t* __restrict__ KW, float* __restrict__ SC, int vbase, int bid, int nb, int tid) {
    const int wid = tid >> 6, lane = tid & 63, ln = lane & 31, hl = lane >> 5;
    const int nw = nb * 8, NV = 8320;
    int v = vbase + ((((bid * 8 + wid) - vbase) % nw) + nw) % nw;
    for (; v < vbase + NV; v += nw) {
        const int vv = v - vbase, tri = vv >> 2, sub = vv & 3;
        int q4 = (int)((__builtin_sqrtf(8.0f * (float)tri + 1.0f) - 1.0f) * 0.5f);
        while ((q4 + 1) * (q4 + 2) / 2 <= tri) ++q4;
        while (q4 * (q4 + 1) / 2 > tri) --q4;
        const int kt = tri - q4 * (q4 + 1) / 2, qblk = 4 * q4 + sub, tq = 32 * qblk + ln, kbase = 128 * kt;
        bf16x8 ka[4][4];
#pragma unroll
        for (int uu = 0; uu < 4; ++uu)
#pragma unroll
            for (int s = 0; s < 4; ++s) ka[uu][s] = *(const bf16x8*)(KW + (size_t)(kbase + 32 * uu + ln) * 256 + 16 * s + 8 * hl);
        f32x16 sc[4];
#pragma unroll
        for (int uu = 0; uu < 4; ++uu)
#pragma unroll
            for (int i = 0; i < 16; ++i) sc[uu][i] = 0.f;
#pragma unroll 1
        for (int hp = 0; hp < 4; ++hp) {
            bf16x8 qb[2][4];
#pragma unroll
            for (int hh = 0; hh < 2; ++hh)
#pragma unroll
                for (int s = 0; s < 4; ++s) qb[hh][s] = *(const bf16x8*)(Qi + (size_t)tq * 512 + (2 * hp + hh) * 64 + 16 * s + 8 * hl);
            const unsigned wpk = *(const unsigned*)(KW + (size_t)tq * 256 + 64 + 2 * hp); const float wa = bflo(wpk) * IDX_SCALE, wb = bfhi(wpk) * IDX_SCALE;
#pragma unroll
            for (int uu = 0; uu < 4; ++uu)
#pragma unroll
                for (int hh = 0; hh < 2; ++hh) {
                    f32x16 t;
#pragma unroll
                    for (int i = 0; i < 16; ++i) t[i] = 0.f;
#pragma unroll
                    for (int s = 0; s < 4; ++s) t = mfma32(ka[uu][s], qb[hh][s], t);
                    const float w = hh ? wb : wa;
#pragma unroll
                    for (int i = 0; i < 16; ++i) sc[uu][i] += w * fmaxf(t[i], 0.f);
                }
        }
#pragma unroll
        for (int uu = 0; uu < 4; ++uu)
#pragma unroll
            for (int g = 0; g < 4; ++g)
                { const int key0 = kbase + 32 * uu + 8 * g + 4 * hl;
                  if (key0 <= (tq | 3)) *(f32x4*)(SC + sc_rowoff(tq) + key0) = (f32x4){sc[uu][4 * g], sc[uu][4 * g + 1], sc[uu][4 * g + 2], sc[uu][4 * g + 3]}; }
    }
}
constexpr int DS_ROW = 544;
constexpr int DS_TILE = 32 * DS_ROW;
__device__ __forceinline__ void dsa_phase(LAS unsigned char* lds, const float* __restrict__ SC, const bf16_t* __restrict__ CN, const bf16_t* __restrict__ QP, bf16_t* __restrict__ OP, int bid, int nb, int tid) {
    const int wid = __builtin_amdgcn_readfirstlane(tid >> 6), lane = tid & 63, hn = lane & 15, g = lane >> 4;
    LAS unsigned char* tile = lds + wid * DS_TILE;
    LAS unsigned short* list = (LAS unsigned short*)(lds + 8 * DS_TILE + wid * 512);
    const int gw = bid * 8 + wid, nw = nb * 8;
    for (int rr = gw; rr < SEQ; rr += nw) {
        const int blk = rr / nw, pos = rr % nw; const int t = (blk & 1) ? (blk * nw + (nw - 1 - pos)) : rr;
        const int n = t + 1; int nvalid;
        if (n <= 256) {
            nvalid = n;
#pragma unroll
            for (int i = 0; i < 4; ++i) { const int e = i * 64 + lane; list[e] = (unsigned short)(e < n ? e : t); }
        } else {
            nvalid = 256;
            const int nI = (n + 63) >> 6;
            unsigned key[128];
            const float* row = SC + sc_rowoff(t);
#pragma unroll
            for (int i = 0; i < 128; ++i) {
                unsigned k = 0u;
                if (i < nI) { const int e = i * 64 + lane; if (e < n) { const unsigned b = __float_as_uint(row[e]); k = (b & 0x80000000u) ? ~b : (b | 0x80000000u); } }
                key[i] = k;
            }
            unsigned T = 0u;
            for (int bit = 31; bit >= 0; --bit) {
                const unsigned cand = T | (1u << bit); int cnt = 0;
#pragma unroll
                for (int i0 = 0; i0 < 128; i0 += 16) if (i0 < nI) {
#pragma unroll
                    for (int i = i0; i < i0 + 16; ++i) cnt += __popcll(__ballot(key[i] >= cand));
                }
                if (cnt >= 256) T = cand;
            }
            int cgt = 0;
#pragma unroll
            for (int i0 = 0; i0 < 128; i0 += 16) if (i0 < nI) {
#pragma unroll
                for (int i = i0; i < i0 + 16; ++i) cgt += __popcll(__ballot(key[i] > T));
            }
            const int need = 256 - cgt;
            int obase = 0, ebase = 0; const unsigned long long ltm = (1ull << lane) - 1ull;
#pragma unroll
            for (int i0 = 0; i0 < 128; i0 += 16) if (i0 < nI) {
#pragma unroll
                for (int i = i0; i < i0 + 16; ++i) {
                    const bool gt = key[i] > T, eq = key[i] == T;
                    const unsigned long long meq = __ballot(eq);
                    const bool selq = gt || (eq && (ebase + __popcll(meq & ltm) < need));
                    const unsigned long long ms = __ballot(selq);
                    if (selq) list[obase + __popcll(ms & ltm)] = (unsigned short)(i * 64 + lane);
                    obase += __popcll(ms); ebase += __popcll(meq);
                }
            }
        }
        bf16x8 bq[8];
#pragma unroll
        for (int s = 0; s < 8; ++s) { u32x4 v = (u32x4){0u, 0u, 0u, 0u}; if (hn < 6) v = *(const u32x4*)(QP + (size_t)t * 1536 + hn * 256 + 32 * s + 8 * g); bq[s] = as_bf16x8(v); }
        f32x4 O[16];
#pragma unroll
        for (int c = 0; c < 16; ++c) O[c] = (f32x4){0.f, 0.f, 0.f, 0.f};
        float mrun = -1e30f, lsum = 0.f;
        const int nch = (nvalid + 31) >> 5;
        for (int ch = 0; ch < nch; ++ch) {
#pragma unroll 1
            for (int hf = 0; hf < 2; ++hf) {
                u32x4 gv[8];
#pragma unroll
                for (int it = 0; it < 8; ++it) { const int idx = list[ch * 32 + 16 * hf + 2 * it + (lane >> 5)]; gv[it] = *(const u32x4*)(CN + (size_t)idx * 256 + (lane & 31) * 8); }
#pragma unroll
                for (int it = 0; it < 8; ++it) *(LAS u32x4*)(tile + (16 * hf + 2 * it + (lane >> 5)) * DS_ROW + (lane & 31) * 16) = gv[it];
            }
            f32x4 st[2];
#pragma unroll
            for (int rb = 0; rb < 2; ++rb) { st[rb] = (f32x4){0.f, 0.f, 0.f, 0.f};
#pragma unroll
                for (int s = 0; s < 8; ++s) { const bf16x8 a = *(const LAS bf16x8*)(tile + (16 * rb + hn) * DS_ROW + (32 * s + 8 * g) * 2); st[rb] = mfma16(a, bq[s], st[rb]); } }
            float mx = -1e30f;
#pragma unroll
            for (int rb = 0; rb < 2; ++rb)
#pragma unroll
                for (int i = 0; i < 4; ++i) { const int slot = ch * 32 + 16 * rb + 4 * g + i; st[rb][i] = (slot < nvalid) ? st[rb][i] : -1e30f; mx = fmaxf(mx, st[rb][i]); }
            mx = fmaxf(mx, __shfl_xor(mx, 16)); mx = fmaxf(mx, __shfl_xor(mx, 32));
            const float mnew = fmaxf(mrun, mx), alpha = __builtin_amdgcn_exp2f(mrun - mnew);
            float ps = 0.f; float p[8];
#pragma unroll
            for (int rb = 0; rb < 2; ++rb)
#pragma unroll
                for (int i = 0; i < 4; ++i) { p[4 * rb + i] = __builtin_amdgcn_exp2f(st[rb][i] - mnew); ps += p[4 * rb + i]; }
            ps += __shfl_xor(ps, 16); ps += __shfl_xor(ps, 32);
            lsum = lsum * alpha + ps; mrun = mnew;
#pragma unroll
            for (int c = 0; c < 16; ++c) O[c] *= alpha;
            u32x4 pw; pw.x = cvt_pk_bf16(p[0], p[1]); pw.y = cvt_pk_bf16(p[2], p[3]); pw.z = cvt_pk_bf16(p[4], p[5]); pw.w = cvt_pk_bf16(p[6], p[7]);
            const bf16x8 pb = as_bf16x8(pw);
            LAS unsigned char* a_lo = tile + (4 * g + (hn >> 2)) * DS_ROW + 8 * (hn & 3);
            LAS unsigned char* a_hi = a_lo + 16 * DS_ROW;
#pragma unroll
            for (int c = 0; c < 16; ++c) {
                const bf16x4 lo = __builtin_amdgcn_ds_read_tr16_b64_v4i16((LAS bf16x4*)(a_lo + 32 * c));
                const bf16x4 hi = __builtin_amdgcn_ds_read_tr16_b64_v4i16((LAS bf16x4*)(a_hi + 32 * c));
                const bf16x8 a = __builtin_shufflevector(lo, hi, 0, 1, 2, 3, 4, 5, 6, 7);
                O[c] = mfma16(a, pb, O[c]);
            }
        }
        const float inv = 1.0f / lsum;
        if (hn < 6) {
#pragma unroll
            for (int c = 0; c < 16; ++c) { u32x2 w; w.x = cvt_pk_bf16(O[c][0] * inv, O[c][1] * inv); w.y = cvt_pk_bf16(O[c][2] * inv, O[c][3] * inv);
                *(u32x2*)(OP + (size_t)t * 1536 + hn * 256 + 16 * c + 4 * g) = w; }
        }
    }
}

constexpr int RW_STRIDE = 2052;
__device__ __forceinline__ void ln_router_phase(LAS unsigned char* lds, float* X1  , const float* __restrict__ lg, const float* __restrict__ lb, const float* __restrict__ wr,
                                int* __restrict__ EID, float* __restrict__ GW, unsigned* __restrict__ ctl, int bid, int nb, int tid) {
    const int wid = tid >> 6, lane = tid & 63;
    LAS float* W = (LAS float*)lds; LAS int* tokE = (LAS int*)(lds + 16 * RW_STRIDE * 4);
    for (int idx = tid; idx < 2048 * 16; idx += NTHR) W[(idx & 15) * RW_STRIDE + (idx >> 4)] = wr[idx];
    __syncthreads();
    for (int cb = bid; cb < 256; cb += nb) {
        for (int k4 = 0; k4 < 4; ++k4) {
            const int tl = 4 * wid + k4, t = 32 * cb + tl;
            f32x4 x[8]; float s = 0.f;
#pragma unroll
            for (int k = 0; k < 8; ++k) { x[k] = *(const f32x4*)(X1 + (size_t)t * 2048 + 256 * k + 4 * lane); s += (x[k][0] + x[k][1]) + (x[k][2] + x[k][3]); }
            const float mu = wave_sum(s) * (1.0f / 2048.0f);
            float q = 0.f;
#pragma unroll
            for (int k = 0; k < 8; ++k) { const f32x4 d = x[k] - mu; q += (d[0] * d[0] + d[1] * d[1]) + (d[2] * d[2] + d[3] * d[3]); }
            const float rstd = __builtin_amdgcn_rsqf(wave_sum(q) * (1.0f / 2048.0f) + 1e-5f);
#pragma unroll
            for (int k = 0; k < 8; ++k) { const f32x4 gg = *(const f32x4*)(lg + 256 * k + 4 * lane), bb = *(const f32x4*)(lb + 256 * k + 4 * lane);
                x[k] = (x[k] - mu) * rstd * gg + bb;
                *(f32x4*)(X1 + (size_t)t * 2048 + 256 * k + 4 * lane) = x[k]; }
            float ex[16];
#pragma unroll
            for (int e = 0; e < 16; ++e) { float p = 0.f;
#pragma unroll
                for (int k = 0; k < 8; ++k) { const f32x4 w = *(const LAS f32x4*)(W + e * RW_STRIDE + 256 * k + 4 * lane); p += (x[k][0] * w[0] + x[k][1] * w[1]) + (x[k][2] * w[2] + x[k][3] * w[3]); }
                ex[e] = wave_sum(p); }
            float mx = ex[0];
#pragma unroll
            for (int e = 1; e < 16; ++e) mx = fmaxf(mx, ex[e]);
#pragma unroll
            for (int e = 0; e < 16; ++e) ex[e] = __expf(ex[e] - mx);
            float gs[4];
#pragma unroll
            for (int g = 0; g < 4; ++g) { const float a = ex[4 * g], b = ex[4 * g + 1], c = ex[4 * g + 2], d = ex[4 * g + 3];
                const float h1 = fmaxf(a, b), l1 = fminf(a, b), h2 = fmaxf(c, d), l2 = fminf(c, d);
                gs[g] = fmaxf(h1, h2) + fmaxf(fminf(h1, h2), fmaxf(l1, l2)); }
            int gsel = 0; float gbest = gs[0];
#pragma unroll
            for (int g = 1; g < 4; ++g) if (gs[g] > gbest) { gbest = gs[g]; gsel = g; }
            float v[4];
#pragma unroll
            for (int j = 0; j < 4; ++j) v[j] = gsel == 0 ? ex[j] : (gsel == 1 ? ex[4 + j] : (gsel == 2 ? ex[8 + j] : ex[12 + j]));
            int i0 = 0; float v0 = v[0];
#pragma unroll
            for (int j = 1; j < 4; ++j) if (v[j] > v0) { v0 = v[j]; i0 = j; }
            int i1 = (i0 + 1) & 3; float v1 = -1.f;
#pragma unroll
            for (int j = 0; j < 4; ++j) if (j != i0 && v[j] > v1) { v1 = v[j]; i1 = j; }
            const float inv = 1.0f / (v0 + v1);
            if (lane == 0) { const int e0 = 4 * gsel + i0, e1 = 4 * gsel + i1; tokE[2 * tl] = e0; tokE[2 * tl + 1] = e1;
                EID[2 * t] = e0; EID[2 * t + 1] = e1; GW[2 * t] = v0 * inv; GW[2 * t + 1] = v1 * inv; }
        }
        __syncthreads();
        if (tid < 16) { int c = 0; for (int i = 0; i < 64; ++i) c += (tokE[i] == tid) ? 1 : 0; ctl[CW_BCNT + cb * 16 + tid] = (unsigned)c; }
        __syncthreads();
    }
}
__device__ __forceinline__ void dispatch_phase(LAS unsigned char* lds, const float* __restrict__ X1, const int* __restrict__ EID, const float* __restrict__ GW, int* __restrict__ SLOT, float* __restrict__ SGW,
                               bf16_t* __restrict__ XS, unsigned* __restrict__ ctl, int bid, int nb, int tid) {
    LAS int* tot = (LAS int*)lds; LAS int* pre = tot + 16; LAS int* off = tot + 32; LAS int* slot = tot + 64; LAS int* eidl = tot + 128;
    for (int cb = bid; cb < 256; cb += nb) {
        if (tid < 32) { tot[tid] = 0; }
        __syncthreads();
        {
            const int e = tid & 15, part = tid >> 4; int tt = 0, pp = 0;
#pragma unroll
            for (int k = 0; k < 8; ++k) { const int b = part * 8 + k; const int c = (int)ctl[CW_BCNT + b * 16 + e]; tt += c; pp += (b < cb) ? c : 0; }
            __hip_atomic_fetch_add(tot + e, tt, __ATOMIC_RELAXED, __HIP_MEMORY_SCOPE_WORKGROUP); __hip_atomic_fetch_add(pre + e, pp, __ATOMIC_RELAXED, __HIP_MEMORY_SCOPE_WORKGROUP); }
        __syncthreads();
        if (tid == 0) { int base = 0;
            for (int e = 0; e < 16; ++e) { off[e] = base + pre[e]; const int nt = (tot[e] + 255) >> 8;
                if (cb == 0) for (int k = 0; k < nt; ++k) ctl[CW_TEXP + (base >> 8) + k] = (unsigned)e;
                base += nt << 8; }
            if (cb == 0) ctl[CW_NT] = (unsigned)(base >> 8); }
        __syncthreads();
        if (tid < 64) slot[tid] = XS_ROWS - 1;
        __syncthreads();
        if (tid < 64) eidl[tid] = EID[64 * cb + tid];
        __syncthreads();
        if (tid < 64) { const int e = eidl[tid]; int r = 0; for (int i = 0; i < 64; ++i) r += (i < tid && eidl[i] == e) ? 1 : 0; if (e >= 0 && e < 16) slot[tid] = off[e] + r; }
        __syncthreads();
        if (tid < 64) { const int sl = slot[tid]; SLOT[64 * cb + tid] = sl; SGW[sl] = GW[64 * cb + tid]; }
        for (int pr = 0; pr < 64; ++pr) { const int t = 32 * cb + (pr >> 1), sl = slot[pr];
            const f32x4 v = *(const f32x4*)(X1 + (size_t)t * 2048 + tid * 4);
            u32x2 w; w.x = cvt_pk_bf16(v[0], v[1]); w.y = cvt_pk_bf16(v[2], v[3]); *(u32x2*)(XS + (size_t)sl * 2048 + tid * 4) = w; }
        __syncthreads();
    }
}
__device__ __forceinline__ void combine_ln2_phase(const float* __restrict__ X1, const bf16_t* __restrict__ DN, const int* __restrict__ SLOT, const float* __restrict__ lg, const float* __restrict__ lb,
                                  float* __restrict__ outF, bf16_t* __restrict__ outB, int bid, int nb, int tid) {
    const int wid = tid >> 6, lane = tid & 63;
    for (int t = bid * 8 + wid; t < SEQ; t += nb * 8) {
        const int s0 = SLOT[2 * t], s1 = SLOT[2 * t + 1];
        f32x4 x[8]; float s = 0.f;
#pragma unroll
        for (int k = 0; k < 8; ++k) { const f32x4 a = *(const f32x4*)(X1 + (size_t)t * 2048 + 256 * k + 4 * lane);
            const u32x2 d0 = *(const u32x2*)(DN + (size_t)s0 * 2048 + 256 * k + 4 * lane), d1 = *(const u32x2*)(DN + (size_t)s1 * 2048 + 256 * k + 4 * lane);
            x[k][0] = a[0] * ALPHA + (bflo(d0.x) + bflo(d1.x)); x[k][1] = a[1] * ALPHA + (bfhi(d0.x) + bfhi(d1.x));
            x[k][2] = a[2] * ALPHA + (bflo(d0.y) + bflo(d1.y)); x[k][3] = a[3] * ALPHA + (bfhi(d0.y) + bfhi(d1.y));
            s += (x[k][0] + x[k][1]) + (x[k][2] + x[k][3]); }
        const float mu = wave_sum(s) * (1.0f / 2048.0f);
        float q = 0.f;
#pragma unroll
        for (int k = 0; k < 8; ++k) { const f32x4 d = x[k] - mu; q += (d[0] * d[0] + d[1] * d[1]) + (d[2] * d[2] + d[3] * d[3]); }
        const float rstd = __builtin_amdgcn_rsqf(wave_sum(q) * (1.0f / 2048.0f) + 1e-5f);
#pragma unroll
        for (int k = 0; k < 8; ++k) { const f32x4 gg = *(const f32x4*)(lg + 256 * k + 4 * lane), bb = *(const f32x4*)(lb + 256 * k + 4 * lane);
            const f32x4 y = (x[k] - mu) * rstd * gg + bb;
            *(f32x4*)(outF + (size_t)t * 2048 + 256 * k + 4 * lane) = y;
            if (outB) { u32x2 w; w.x = cvt_pk_bf16(y[0], y[1]); w.y = cvt_pk_bf16(y[2], y[3]); *(u32x2*)(outB + (size_t)t * 2048 + 256 * k + 4 * lane) = w; } }
    }
}

#define IN(k) (P.ph_lo <= (k) && (k) < P.ph_hi)
#define SEAM(k) do { if (IN(k) && IN((k) + 1)) xcd_barrier(bar); } while (0)
#define LAUNDER() int tid = tid0, bid = bid0; unsigned char* ws = P.ws; asm volatile("" : "+v"(tid)); asm volatile("" : "+s"(bid)); asm volatile("" : "+s"(ws)); unsigned* ctl = (unsigned*)(ws + WS_CTL);
#ifndef REP_PHASE
#define REP_PHASE -1
#endif
#define REPK(k) for (int rep_ = 0; rep_ < ((REP_PHASE == (k)) ? 2 : 1); ++rep_)
#define REPSYNC(k) do { if (REP_PHASE == (k)) __syncthreads(); } while (0)
template <int l> __device__ __forceinline__ void layer_phases(const Params& P, LAS unsigned char* lds, const XcdBarrier& bar, const int tid0, const int bid0, const int nb) {
        constexpr int pb = 1 + 10 * l;
        if (IN(pb + 0)) REPK(0) {
            LAUNDER()
            ProjSched S{(const char*)(ws + WS_Z), nb, bid}; ProjEpi E{ws};
            pg8::gemm_phase(lds, pg8::Dims{2048, 2048, 2048}, S, E, tid);
            REPSYNC(0);
        } SEAM(pb + 0);
        if (IN(pb + 1)) {
            LAUNDER()
            REPK(11) sb_attn_phase(lds, (const bf16_t*)(ws + WS_QSB), (const bf16_t*)(ws + WS_KSB), (const bf16_t*)(ws + WS_VT), (bf16_t*)(ws + WS_YCAT), 0, bid, nb, tid);
            REPK(12) ret_kv_phase(lds, (const bf16_t*)(ws + WS_KR), (const bf16_t*)(ws + WS_VR), (const f32x2*)(ws + WS_ROT), (float*)(ws + WS_KVT), 192, bid, nb, tid);
            cn_phase((const bf16_t*)(ws + WS_CKV), P.kv_norm_g + l * 256, (bf16_t*)(ws + WS_CN), bid, nb, tid);
            REPK(13) { GridSched S{(const char*)(ws + WS_QD), (const char*)(ws + WS_WABS), 32, 2, 3, (size_t)256 * 768 * 2, (size_t)256 * 256 * 2, (size_t)256 * 2, (size_t)512 * 256 * 2, nb, (bid + 64) % nb};
              Bf16Epi E{(bf16_t*)(ws + WS_QP), 1536, 512, SB_QSCALE};
              pg8::gemm_phase(lds, pg8::Dims{256, 768, 256}, S, E, tid); }
            REPK(14) score_phase((const bf16_t*)(ws + WS_QI), (const bf16_t*)(ws + WS_KW), (float*)(ws + WS_SC), 0, bid, nb, tid);
        } SEAM(pb + 1);
        if (IN(pb + 2)) REPK(2) {
            LAUNDER()
            ret_scan_phase((const float*)(ws + WS_KVT), (bf16_t*)(ws + WS_ST), bid, nb, tid);
            REPK(22) dsa_phase(lds, (const float*)(ws + WS_SC), (const bf16_t*)(ws + WS_CN), (const bf16_t*)(ws + WS_QP), (bf16_t*)(ws + WS_OP), bid, nb, tid);
            REPSYNC(2);
        } SEAM(pb + 2);
        if (IN(pb + 3)) REPK(3) {
            LAUNDER()
            ret_out_phase(lds, (const bf16_t*)(ws + WS_QR), (const bf16_t*)(ws + WS_KR), (const bf16_t*)(ws + WS_VR), (const bf16_t*)(ws + WS_GR), (const f32x2*)(ws + WS_ROT),
                          (const bf16_t*)(ws + WS_ST), P.ret_gn_g + l * 512, (bf16_t*)(ws + WS_YCAT), 0, bid, nb, tid);
            { GridSched S{(const char*)(ws + WS_OP), (const char*)(ws + WS_WUVP), 32, 1, 3, (size_t)256 * 1536 * 2, (size_t)256 * 512 * 2, (size_t)512 * 2, (size_t)256 * 512 * 2, nb, bid};
              Bf16Epi E{(bf16_t*)(ws + WS_YCAT) + 1280, 2048, 256, 1.0f};
              pg8::gemm_phase(lds, pg8::Dims{512, 1536, 512}, S, E, tid); }
            REPSYNC(3);
        } SEAM(pb + 3);
        if (IN(pb + 4)) REPK(4) {
            LAUNDER()
            GridSched S{(const char*)(ws + WS_YCAT), (const char*)(ws + WS_WOT), 32, 8, 1, TS2048, TS2048, 0, 0, nb, bid};
            ResF32Epi E{(float*)(ws + WS_X1), l ? (const float*)P.out : P.x};
            pg8::gemm_phase(lds, pg8::Dims{2048, 2048, 2048}, S, E, tid);
            REPSYNC(4);
        } SEAM(pb + 4);
        if (IN(pb + 5)) {
            LAUNDER()
            ln_router_phase(lds, (float*)(ws + WS_X1), P.ln1_g + l * 2048, P.ln1_b + l * 2048, P.w_router, (int*)(ws + WS_EID), (float*)(ws + WS_GW), ctl, bid, nb, tid);
        } SEAM(pb + 5);
        if (IN(pb + 6)) REPK(6) {
            LAUNDER()
            dispatch_phase(lds, (const float*)(ws + WS_X1), (const int*)(ws + WS_EID), (const float*)(ws + WS_GW), (int*)(ws + WS_SLOT), (float*)(ws + WS_SGW), (bf16_t*)(ws + WS_XS), ctl, bid, nb, tid);
            REPSYNC(6);
        } SEAM(pb + 6);
        if (IN(pb + 7)) REPK(7) {
            LAUNDER()
            MoeSched S{(const char*)(ws + WS_XS), (const char*)(ws + WS_WGU), ctl, 4, TS2048, TS2048, nb, bid};
            GateUpEpi E{(bf16_t*)(ws + WS_ACT), (const float*)(ws + WS_SGW)};
            pg8::gemm_phase(lds, pg8::Dims{2048, 2048, 2048}, S, E, tid);
            REPSYNC(7);
        } SEAM(pb + 7);
        if (IN(pb + 8)) REPK(8) {
            LAUNDER()
            MoeSched S{(const char*)(ws + WS_ACT), (const char*)(ws + WS_WDT), ctl, 8, (size_t)256 * 512 * 2, (size_t)256 * 512 * 2, nb, bid};
            DownEpi E{(bf16_t*)(ws + WS_DN)};
            pg8::gemm_phase(lds, pg8::Dims{512, 512, 512}, S, E, tid);
            REPSYNC(8);
        } SEAM(pb + 8);
        if (IN(pb + 9)) REPK(9) {
            LAUNDER()
            combine_ln2_phase((const float*)(ws + WS_X1), (const bf16_t*)(ws + WS_DN), (const int*)(ws + WS_SLOT), P.ln2_g + l * 2048, P.ln2_b + l * 2048,
                              P.out, l ? (bf16_t*)nullptr : (bf16_t*)(ws + WS_Z), bid, nb, tid);
            if (l == 0) p0_weights(P, ws, lds, 1, bid, nb, tid);
            REPSYNC(9);
        } SEAM(pb + 9);
}
constexpr int NPHASE = 21;
__global__ void __launch_bounds__(NTHR, 2) fwd_kernel(Params P) {
    extern __shared__ __attribute__((aligned(16))) unsigned char smem[];
    LAS unsigned char* lds = (LAS unsigned char*)smem;
    const int tid0 = threadIdx.x, bid0 = blockIdx.x, nb = gridDim.x;
    unsigned* ctl0 = (unsigned*)(P.ws + WS_CTL);
    volatile LAS unsigned* bst = (volatile LAS unsigned*)(lds + LDS_BYTES - 16);
    const bool multi = (P.ph_hi - P.ph_lo) > 1;
    if (tid0 == 0) { bst[0] = 0u; bst[1] = 0u; bst[2] = 0u; bst[3] = 0u; }
    __syncthreads();
    XcdBarrier bar; bar.bar = ctl0 + CW_BAR; bar.x = 0; bar.st = bst;
    if (multi) bar = xcd_barrier_post(ctl0 + CW_BAR, bst);
    if (IN(0)) REPK(100) { LAUNDER() (void)ctl; p0_common(P, ws, bid, nb, tid); p0_weights(P, ws, lds, 0, bid, nb, tid); } SEAM(0);
    layer_phases<0>(P, lds, bar, tid0, bid0, nb);
    layer_phases<1>(P, lds, bar, tid0, bid0, nb);
#undef IN
#undef SEAM
}

#ifndef N_LAUNCHES
#define N_LAUNCHES 1
#endif
extern "C" void kernel_launch(void* const* d_in, const int* in_sizes, int n_in, void* d_out, int out_size, void* d_ws, size_t ws_size, hipStream_t stream) {
    static int grid = 0;
    if (grid == 0) {
        int dev = 0, cus = 0, per_cu = 0;
        if (n_in != 14 || ws_size < WS_END) { fprintf(stderr, "kernel_launch: bad arguments (n_in %d, ws %zu < %zu)\n", n_in, ws_size, (size_t)WS_END); grid = -1; return; }
        if (hipGetDevice(&dev) != hipSuccess || hipDeviceGetAttribute(&cus, hipDeviceAttributeMultiprocessorCount, dev) != hipSuccess) { grid = -1; return; }
        if (hipFuncSetAttribute((const void*)fwd_kernel, hipFuncAttributeMaxDynamicSharedMemorySize, LDS_BYTES) != hipSuccess) { fprintf(stderr, "kernel_launch: hipFuncSetAttribute failed\n"); grid = -1; return; }
        if (hipOccupancyMaxActiveBlocksPerMultiprocessor(&per_cu, (const void*)fwd_kernel, NTHR, LDS_BYTES) != hipSuccess || per_cu < 1) fprintf(stderr, "kernel_launch: occupancy query says %d\n", per_cu);
        (void)hipGetLastError();
        grid = cus;
    }
    if (grid < 0) return;
    (void)hipMemsetAsync((char*)d_ws + WS_CTL, 0, CTL_BYTES, stream);
    Params p{};
    p.x = (const float*)d_in[0]; p.w_in = (const float*)d_in[1]; p.w_kv_up = (const float*)d_in[2]; p.kv_norm_g = (const float*)d_in[3]; p.ret_gn_g = (const float*)d_in[4];
    p.w_o = (const float*)d_in[5]; p.ln1_g = (const float*)d_in[6]; p.ln1_b = (const float*)d_in[7]; p.w_router = (const float*)d_in[8];
    p.w_gate = (const float*)d_in[9]; p.w_up = (const float*)d_in[10]; p.w_down = (const float*)d_in[11]; p.ln2_g = (const float*)d_in[12]; p.ln2_b = (const float*)d_in[13];
    p.out = (float*)d_out; p.ws = (unsigned char*)d_ws;
    if (N_LAUNCHES == 1) { p.ph_lo = 0; p.ph_hi = NPHASE; hipLaunchKernelGGL(fwd_kernel, dim3(grid), dim3(NTHR), LDS_BYTES, stream, p); }
    else for (int k = 0; k < NPHASE; ++k) { p.ph_lo = k; p.ph_hi = k + 1; hipLaunchKernelGGL(fwd_kernel, dim3(grid), dim3(NTHR), LDS_BYTES, stream, p); }
}
```

```cpp
#include <hip/hip_runtime.h>
#include <stdint.h>
#include <stdio.h>

#define LAS __attribute__((address_space(3)))
typedef unsigned short bf16_t;
typedef short bf16x8 __attribute__((ext_vector_type(8)));
typedef short bf16x4 __attribute__((ext_vector_type(4)));
typedef float f32x2 __attribute__((ext_vector_type(2)));
typedef float f32x4 __attribute__((ext_vector_type(4)));
typedef float f32x16 __attribute__((ext_vector_type(16)));
typedef unsigned u32x2 __attribute__((ext_vector_type(2)));
typedef unsigned u32x4 __attribute__((ext_vector_type(4)));

constexpr int SEQ = 8192, DM = 2048, DIN = 5960, NTHR = 512;
constexpr float ALPHA = 1.41421356237309515f;
constexpr float LOG2E = 1.44269504088896341f;
constexpr float SB_QSCALE = 0.08838834764831845f * LOG2E;
constexpr float IDX_SCALE = 0.04419417382415922f;
constexpr int LDS_BYTES = 147456;

constexpr size_t WS_CTL = 0, CTL_BYTES = 65536;
constexpr size_t Z_BYTES = (size_t)(8192 + 6144) * 2048 * 2;
constexpr size_t WS_Z = WS_CTL + CTL_BYTES;
constexpr size_t WS_ROT = WS_Z + Z_BYTES;
constexpr size_t WS_WOT = WS_ROT + (size_t)8192 * 64 * 8;
constexpr size_t WS_WGU = WS_WOT + (size_t)2048 * 2048 * 2;
constexpr size_t WS_WDT = WS_WGU + (size_t)16 * 1024 * 2048 * 2;
constexpr size_t WS_WABS = WS_WDT + (size_t)16 * 2048 * 512 * 2;
constexpr size_t WS_WUVP = WS_WABS + (size_t)3 * 512 * 256 * 2;
constexpr size_t WS_EID = WS_WUVP + (size_t)3 * 256 * 512 * 2;
constexpr size_t WS_GW = WS_EID + (size_t)SEQ * 2 * 4;
constexpr size_t WS_SLOT = WS_GW + (size_t)SEQ * 2 * 4;
constexpr int XS_ROWS = 20480;
constexpr size_t WS_SGW = WS_SLOT + (size_t)SEQ * 2 * 4;
constexpr size_t WS_YCAT = WS_SGW + (size_t)XS_ROWS * 4;
constexpr size_t WS_R = WS_YCAT + (size_t)SEQ * 2048 * 2;
constexpr size_t WS_QSB = WS_R;
constexpr size_t WS_KSB = WS_QSB + (size_t)SEQ * 768 * 2;
constexpr size_t WS_VT = WS_KSB + (size_t)SEQ * 768 * 2;
constexpr size_t WS_QR = WS_VT + (size_t)SEQ * 768 * 2;
constexpr size_t WS_KR = WS_QR + (size_t)SEQ * 512 * 2;
constexpr size_t WS_VR = WS_KR + (size_t)SEQ * 512 * 2;
constexpr size_t WS_GR = WS_VR + (size_t)SEQ * 512 * 2;
constexpr size_t WS_QD = WS_GR + (size_t)SEQ * 512 * 2;
constexpr size_t WS_CKV = WS_QD + (size_t)SEQ * 768 * 2;
constexpr size_t WS_QI = WS_CKV + (size_t)SEQ * 256 * 2;
constexpr size_t WS_KW = WS_QI + (size_t)SEQ * 512 * 2;
constexpr size_t WS_CN = WS_KW + (size_t)SEQ * 256 * 2;
constexpr size_t WS_QP = WS_CN + (size_t)SEQ * 256 * 2;
constexpr size_t WS_KVT = WS_QP + (size_t)SEQ * 1536 * 2;
constexpr size_t WS_ST = WS_KVT + (size_t)4 * 64 * 128 * 128 * 4;
constexpr size_t WS_OP = WS_ST + (size_t)4 * 64 * 128 * 128 * 2;
constexpr size_t WS_SC = WS_OP + (size_t)SEQ * 1536 * 2;
constexpr size_t SC_ELEMS = (size_t)16 * 2048 * 2049 / 2;
constexpr size_t WS_END_ATT = WS_SC + SC_ELEMS * 4;
constexpr size_t WS_X1 = WS_R;
constexpr size_t WS_XS = WS_X1 + (size_t)SEQ * 2048 * 4;
constexpr size_t WS_ACT = WS_XS + (size_t)XS_ROWS * 2048 * 2;
constexpr size_t WS_DN = WS_ACT + (size_t)XS_ROWS * 512 * 2;
constexpr size_t WS_END_FFN = WS_DN + (size_t)XS_ROWS * 2048 * 2;
constexpr size_t WS_END = WS_END_ATT > WS_END_FFN ? WS_END_ATT : WS_END_FFN;
static_assert(WS_END <= (size_t)604313600, "workspace over the guaranteed minimum");
__host__ __device__ __forceinline__ size_t sc_rowoff(int t) { const size_t a = (size_t)(t >> 2), b = (size_t)(t & 3); return 4 * (a + 1) * (2 * a + b); }
constexpr int CW_BAR = 0;
constexpr int CW_NT = 4096;
constexpr int CW_TEXP = 4160;
constexpr int CW_BCNT = 4352;
constexpr int CW_SLOT = 8448;

struct Params {
    const float* x; const float* w_in; const float* w_kv_up; const float* kv_norm_g; const float* ret_gn_g;
    const float* w_o; const float* ln1_g; const float* ln1_b; const float* w_router;
    const float* w_gate; const float* w_up; const float* w_down; const float* ln2_g; const float* ln2_b;
    float* out; unsigned char* ws; int ph_lo, ph_hi;
};

__device__ __forceinline__ unsigned cvt_pk_bf16(float lo, float hi) { unsigned r; asm("v_cvt_pk_bf16_f32 %0, %1, %2" : "=v"(r) : "v"(lo), "v"(hi)); return r; }
__device__ __forceinline__ float bflo(unsigned u) { return __uint_as_float(u << 16); }
__device__ __forceinline__ float bfhi(unsigned u) { return __uint_as_float(u & 0xffff0000u); }
__device__ __forceinline__ float wave_sum(float v) {
#pragma unroll
    for (int m = 32; m >= 1; m >>= 1) v += __shfl_xor(v, m);
    return v;
}
__device__ __forceinline__ f32x16 mfma32(bf16x8 a, bf16x8 b, f32x16 c) { return __builtin_amdgcn_mfma_f32_32x32x16_bf16(a, b, c, 0, 0, 0); }
__device__ __forceinline__ f32x4 mfma16(bf16x8 a, bf16x8 b, f32x4 c) { return __builtin_amdgcn_mfma_f32_16x16x32_bf16(a, b, c, 0, 0, 0); }
__device__ __forceinline__ bf16x8 as_bf16x8(u32x4 v) { return __builtin_bit_cast(bf16x8, v); }

#define XB_TMO      128
#define XB_XCNT(j)  (256  + 64 * (j))
#define XB_XSUB(j)  (1280 + 64 * (j))
#define XB_XGEN(j)  (2304 + 64 * (j))
#define XB_TOP      3328
#define XB_TOPGEN   3392
#define XCD_BAR_WORDS 3456
#define XB_SPIN_CAP (1u << 22)
__device__ __forceinline__ unsigned xb_ld(unsigned* p)              { return __hip_atomic_load(p, __ATOMIC_RELAXED, __HIP_MEMORY_SCOPE_AGENT); }
__device__ __forceinline__ unsigned xb_add(unsigned* p, unsigned v) { return __hip_atomic_fetch_add(p, v, __ATOMIC_RELAXED, __HIP_MEMORY_SCOPE_AGENT); }
__device__ __forceinline__ unsigned xb_xcc_id() { return (unsigned)__builtin_amdgcn_s_getreg((3 << 11) | 20) & 0xFu; }
#define XB_SPIN(cond, bar) do { unsigned _sp = 0; while (cond) { __builtin_amdgcn_s_sleep(1); \
    if ((++_sp & 255u) == 0u) { if (xb_ld(&(bar)[XB_TMO])) break; if (_sp > XB_SPIN_CAP) { atomicAdd(&(bar)[XB_TMO], 1u); break; } } } } while (0)
struct XcdBarrier { unsigned* bar; unsigned x; volatile LAS unsigned* st; };
__device__ __forceinline__ XcdBarrier xcd_barrier_post(unsigned* bar, volatile LAS unsigned* st) {
    XcdBarrier b; b.bar = bar; b.x = xb_xcc_id(); b.st = st;
    if (threadIdx.x == 0) (void)xb_add(&bar[XB_XCNT(b.x)], 1u);
    return b;
}
__device__ __forceinline__ void xcd_barrier_complete(unsigned* bar, unsigned x, unsigned& nloc, unsigned& nx) {
    const unsigned G = gridDim.x * gridDim.y * gridDim.z;
    unsigned sum, cnt, mine, sp = 0u;
    for (;;) {
        sum = 0u; cnt = 0u; mine = 0u;
#pragma unroll
        for (unsigned j = 0; j < 16; ++j) { const unsigned c = xb_ld(&bar[XB_XCNT(j)]); sum += c; cnt += (c > 0u) ? 1u : 0u; mine = (j == x) ? c : mine; }
        if (sum == G) break;
        __builtin_amdgcn_s_sleep(1);
        if ((++sp & 255u) == 0u) { if (xb_ld(&bar[XB_TMO])) break; if (sp > XB_SPIN_CAP) { atomicAdd(&bar[XB_TMO], 1u); break; } }
    }
    nloc = mine > 0u ? mine : 1u; nx = cnt > 0u ? cnt : 1u;
}
__device__ __forceinline__ void xcd_barrier(const XcdBarrier& b, const int wid0) {
    asm volatile("s_waitcnt vmcnt(0)" ::: "memory");
    __syncthreads();
    if (wid0 == 0 && __builtin_amdgcn_mbcnt_hi(~0u, __builtin_amdgcn_mbcnt_lo(~0u, 0u)) == 0u) {
        unsigned* bar = b.bar;
        __builtin_amdgcn_s_waitcnt(0);
        unsigned nloc = b.st[0], nx = b.st[1];
        if (nloc == 0u) { xcd_barrier_complete(bar, b.x, nloc, nx); b.st[0] = nloc; b.st[1] = nx; }
        const unsigned old = xb_add(&bar[XB_XSUB(b.x)], 1u);
        const unsigned gen = old / nloc;
        if (old + 1u == (gen + 1u) * nloc) {
            __builtin_amdgcn_fence(__ATOMIC_RELEASE, "agent");
            asm volatile("s_waitcnt vmcnt(0)" ::: "memory");
            const unsigned og = xb_add(&bar[XB_TOP], 1u);
            const unsigned tg = og / nx;
            if (og + 1u == (tg + 1u) * nx) xb_add(&bar[XB_TOPGEN], 1u);
            else XB_SPIN(xb_ld(&bar[XB_TOPGEN]) == tg, bar);
            __builtin_amdgcn_fence(__ATOMIC_ACQUIRE, "agent");
            xb_add(&bar[XB_XGEN(b.x)], 1u);
            asm volatile("s_waitcnt vmcnt(0)" ::: "memory");
        } else {
            XB_SPIN(xb_ld(&bar[XB_XGEN(b.x)]) == gen, bar);
            __builtin_amdgcn_fence(__ATOMIC_ACQUIRE, "agent");
            asm volatile("s_waitcnt vmcnt(0)" ::: "memory");
        }
    }
    __syncthreads();
}

namespace pg8 {
constexpr int BM = 256, BK = 64, HALF = 128, HTB = HALF * BK * 2, STAGE_BYTES = 8 * HTB;
__device__ __forceinline__ void stage_rc(int b, int& R, int& C) { const int st = b / 1024, sb = b % 1024, swz = sb ^ (((sb >> 9) & 1) << 5); R = (st >> 1) * 16 + swz / 64; C = (st & 1) * 32 + (swz % 64) / 2; }
__device__ __forceinline__ int lds_byte(int r, int c) { const int st = (r >> 4) * 2 + (c >> 5), rr = r & 15, cc = c & 31, ob = rr * 64 + cc * 2; return st * 1024 + (ob ^ (((ob >> 9) & 1) << 5)); }
__device__ __forceinline__ int perm32(int rho) { const int n = rho >> 4, i = rho & 15; return 8 * (i >> 2) + 4 * n + (i & 3); }
struct Unit { int pm, pn, kind; const char* pa; const char* pb; };
struct Dims { int K, lda, ldb; };

template <class Epi, class Sched>
__device__ __forceinline__ void gemm_phase(LAS unsigned char* lds, const Dims g, const Sched& S, const Epi& E, const int tid) {
    const int wid = __builtin_amdgcn_readfirstlane(tid >> 6), lane = tid & 63, wr = wid >> 2, wc = wid & 3, fr = lane & 15, fq = lane >> 4;
    const int K = g.K, nt = K / BK;
    unsigned voffA[2], voffB[2];
#pragma unroll
    for (int i = 0; i < 2; ++i) { int R, C; stage_rc(tid * 16 + i * 8192, R, C); const int Rb = (R & ~31) + perm32(R & 31);
        voffA[i] = (unsigned)(R * g.lda + C) * 2u; voffB[i] = (unsigned)(Rb * g.ldb + C) * 2u; }
    const size_t kstep = (size_t)(BK * 2);
    const size_t hstepA = (size_t)HALF * g.lda * 2, hstepB = (size_t)HALF * g.ldb * 2;
    const unsigned ldsw = (unsigned)wid * 1024u;
    const int aoff = lds_byte(wr * 64 + fr, fq * 8), boff = lds_byte(wc * 32 + fr, fq * 8);
#define PG8_SA(b, h) (((b) * 2 + (h)) * HTB)
#define PG8_SB(b, h) ((4 + (b) * 2 + (h)) * HTB)
#define PG8_STAGE(bufoff, gbase, voff) do { _Pragma("unroll") for (int _i = 0; _i < 2; ++_i) \
        __builtin_amdgcn_global_load_lds((const unsigned*)((const char*)(gbase) + (voff)[_i]), (LAS unsigned*)(lds + (bufoff) + ldsw + _i * 8192), 16, 0, 0); } while (0)
#define PG8_LDA(dst, b, h) do { _Pragma("unroll") for (int m = 0; m < 4; ++m) _Pragma("unroll") for (int k = 0; k < 2; ++k) dst[m][k] = *(const LAS bf16x8*)(lds + PG8_SA(b, h) + aoff + m * 2048 + k * 1024); } while (0)
#define PG8_LDB(dst, b, h) do { _Pragma("unroll") for (int n = 0; n < 2; ++n) _Pragma("unroll") for (int k = 0; k < 2; ++k) dst[n][k] = *(const LAS bf16x8*)(lds + PG8_SB(b, h) + boff + n * 2048 + k * 1024); } while (0)
#define PG8_MMA(ai, bj, At, Bt) do { __builtin_amdgcn_s_setprio(1); _Pragma("unroll") for (int m = 0; m < 4; ++m) _Pragma("unroll") for (int n = 0; n < 2; ++n) _Pragma("unroll") for (int k = 0; k < 2; ++k) \
        acc[ai][bj][m][n] = __builtin_amdgcn_mfma_f32_16x16x32_bf16(Bt[n][k], At[m][k], acc[ai][bj][m][n], 0, 0, 0); __builtin_amdgcn_s_setprio(0); } while (0)
#define PG8_WAIT_V(n) asm volatile("s_waitcnt vmcnt(" #n ")" ::: "memory")
#define PG8_WAIT_L(n) asm volatile("s_waitcnt lgkmcnt(" #n ")" ::: "memory")
#define PG8_BAR __builtin_amdgcn_s_barrier()
#define PG8_SCHED __builtin_amdgcn_sched_barrier(0)
    Unit cur, nxt; int ui = 0;
    if (!S.next(0, cur)) return;
    f32x4 acc[2][2][4][2];
#pragma unroll
    for (int a = 0; a < 2; ++a)
#pragma unroll
        for (int b = 0; b < 2; ++b)
#pragma unroll
            for (int m = 0; m < 4; ++m)
#pragma unroll
                for (int n = 0; n < 2; ++n) acc[a][b][m][n] = (f32x4){0.f, 0.f, 0.f, 0.f};
    bf16x8 At[4][2], B0[2][2], B1[2][2];
    const char* cA = cur.pa; const char* cB = cur.pb;
    PG8_STAGE(PG8_SB(0, 0), cB, voffB); PG8_STAGE(PG8_SA(0, 0), cA, voffA); PG8_STAGE(PG8_SB(0, 1), cB + hstepB, voffB); PG8_STAGE(PG8_SA(0, 1), cA + hstepA, voffA);
    if (wr == 1) PG8_BAR;
    PG8_WAIT_V(4); PG8_BAR;
    PG8_STAGE(PG8_SB(1, 0), cB + kstep, voffB); PG8_STAGE(PG8_SA(1, 0), cA + kstep, voffA); PG8_STAGE(PG8_SB(1, 1), cB + hstepB + kstep, voffB);
    PG8_WAIT_V(6); PG8_BAR;
    for (;;) {
        const bool has_next = S.next(ui + 1, nxt);
        const char* nA = has_next ? nxt.pa : cA; const char* nB = has_next ? nxt.pb : cB;
        for (int t = 0; t < nt; t += 2) {
            const bool last = (t == nt - 2);
            const char* a1 = cA + (size_t)(t + 1) * kstep;
            const char* a2 = last ? nA : cA + (size_t)(t + 2) * kstep; const char* b2 = last ? nB : cB + (size_t)(t + 2) * kstep;
            const char* a3 = a2 + kstep; const char* b3 = b2 + kstep;
            PG8_LDB(B0, 0, 0); PG8_SCHED; PG8_LDA(At, 0, 0); PG8_STAGE(PG8_SA(1, 1), a1 + hstepA, voffA);
            PG8_WAIT_L(8); PG8_BAR; PG8_WAIT_L(0); PG8_MMA(0, 0, At, B0); PG8_BAR; PG8_SCHED;
            PG8_LDB(B1, 0, 1); PG8_STAGE(PG8_SB(0, 0), b2, voffB);
            PG8_BAR; PG8_WAIT_L(0); PG8_MMA(0, 1, At, B1); PG8_BAR;
            PG8_LDA(At, 0, 1); PG8_STAGE(PG8_SA(0, 0), a2, voffA);
            PG8_BAR; PG8_WAIT_L(0); PG8_MMA(1, 0, At, B0); PG8_BAR; PG8_SCHED;
            PG8_STAGE(PG8_SB(0, 1), b2 + hstepB, voffB);
            PG8_WAIT_V(6); PG8_BAR; PG8_MMA(1, 1, At, B1); PG8_BAR;
            PG8_LDB(B0, 1, 0); PG8_SCHED; PG8_LDA(At, 1, 0); PG8_STAGE(PG8_SA(0, 1), a2 + hstepA, voffA);
            PG8_WAIT_L(8); PG8_BAR; PG8_WAIT_L(0); PG8_MMA(0, 0, At, B0); PG8_BAR; PG8_SCHED;
            PG8_LDB(B1, 1, 1); PG8_STAGE(PG8_SB(1, 0), b3, voffB);
            PG8_BAR; PG8_WAIT_L(0); PG8_MMA(0, 1, At, B1); PG8_BAR;
            PG8_LDA(At, 1, 1); PG8_STAGE(PG8_SA(1, 0), a3, voffA);
            PG8_BAR; PG8_WAIT_L(0); PG8_MMA(1, 0, At, B0); PG8_BAR; PG8_SCHED;
            PG8_STAGE(PG8_SB(1, 1), b3 + hstepB, voffB);
            PG8_WAIT_V(6); PG8_BAR; PG8_MMA(1, 1, At, B1); PG8_BAR;
        }
        { int fr2 = fr, fq2 = fq; asm volatile("" : "+v"(fr2), "+v"(fq2));
          E(acc, cur, wr, wc, fr2, fq2); }
        if (!has_next) break;
#pragma unroll
        for (int a = 0; a < 2; ++a)
#pragma unroll
            for (int b = 0; b < 2; ++b)
#pragma unroll
                for (int m = 0; m < 4; ++m)
#pragma unroll
                    for (int n = 0; n < 2; ++n) acc[a][b][m][n] = (f32x4){0.f, 0.f, 0.f, 0.f};
        cur = nxt; cA = nA; cB = nB; ++ui;
    }
    PG8_WAIT_V(0);
    if (wr == 0) PG8_BAR;
    PG8_BAR;
#undef PG8_SA
#undef PG8_SB
#undef PG8_STAGE
#undef PG8_LDA
#undef PG8_LDB
#undef PG8_MMA
#undef PG8_WAIT_V
#undef PG8_WAIT_L
#undef PG8_BAR
#undef PG8_SCHED
}
typedef f32x4 Acc[2][2][4][2];
__device__ __forceinline__ void store_bf16_tile(const Acc& acc, bf16_t* base, int ldc, float scale, int wr, int wc, int fr, int fq) {
#pragma unroll
    for (int ai = 0; ai < 2; ++ai)
#pragma unroll
        for (int m = 0; m < 4; ++m) {
            bf16_t* rowp = base + (size_t)(ai * HALF + wr * 64 + m * 16 + fr) * ldc + wc * 32 + 8 * fq;
#pragma unroll
            for (int bj = 0; bj < 2; ++bj) {
                const f32x4 v0 = acc[ai][bj][m][0] * scale, v1 = acc[ai][bj][m][1] * scale;
                u32x4 w; w.x = cvt_pk_bf16(v0[0], v0[1]); w.y = cvt_pk_bf16(v0[2], v0[3]); w.z = cvt_pk_bf16(v1[0], v1[1]); w.w = cvt_pk_bf16(v1[2], v1[3]);
                *(u32x4*)(rowp + bj * HALF) = w;
            }
        }
}
}

constexpr size_t TS2048 = (size_t)256 * 2048 * 2;
struct ProjSched {
    const char* Z; int G, c;
    __device__ bool next(int i, pg8::Unit& u) const {
        const int L = i * G + c; if (L >= 768) return false;
        if (L < 672) { u.pm = L / 21; u.pn = L % 21; u.kind = 0; u.pa = Z + (size_t)u.pm * TS2048; u.pb = Z + (size_t)(32 + u.pn) * TS2048; }
        else { const int L2 = L - 672; u.pm = 21 + L2 / 32; u.pn = L2 % 32; u.kind = 1; u.pa = Z + (size_t)(32 + u.pm) * TS2048; u.pb = Z + (size_t)u.pn * TS2048; }
        return true;
    }
};
struct ProjEpi {
    unsigned char* ws;
    __device__ __forceinline__ void operator()(const pg8::Acc& acc, const pg8::Unit& u, int wr, int wc, int fr, int fq) const {
        if (u.kind == 0) {
            const int j = u.pn; const size_t r0 = (size_t)u.pm * 256;
            {
                size_t off; int ld, ct; float sc = 1.0f;
                if (j < 3)       { off = WS_QSB; ld = 768; ct = j; sc = SB_QSCALE; }
                else if (j < 6)  { off = WS_KSB; ld = 768; ct = j - 3; }
                else if (j < 8)  { off = WS_QR; ld = 512; ct = j - 6; }
                else if (j < 10) { off = WS_KR; ld = 512; ct = j - 8; }
                else if (j < 12) { off = WS_VR; ld = 512; ct = j - 10; }
                else if (j < 14) { off = WS_GR; ld = 512; ct = j - 12; }
                else if (j < 17) { off = WS_QD; ld = 768; ct = j - 14; }
                else if (j < 18) { off = WS_CKV; ld = 256; ct = 0; }
                else if (j < 20) { off = WS_QI; ld = 512; ct = j - 18; }
                else             { off = WS_KW; ld = 256; ct = 0; }
                pg8::store_bf16_tile(acc, (bf16_t*)(ws + off) + r0 * ld + ct * 256, ld, sc, wr, wc, fr, fq);
            }
        } else {
            bf16_t* base = (bf16_t*)(ws + WS_VT) + (size_t)(u.pm - 21) * 256 * SEQ + (size_t)u.pn * 256;
#pragma unroll
            for (int ai = 0; ai < 2; ++ai)
#pragma unroll
                for (int m = 0; m < 4; ++m) { bf16_t* rowp = base + (size_t)(ai * 128 + wr * 64 + m * 16 + fr) * SEQ + wc * 32 + 16 * (fq >> 1) + 4 * (fq & 1);
#pragma unroll
                    for (int bj = 0; bj < 2; ++bj) { const f32x4 v0 = acc[ai][bj][m][0], v1 = acc[ai][bj][m][1];
                        u32x2 w0, w1; w0.x = cvt_pk_bf16(v0[0], v0[1]); w0.y = cvt_pk_bf16(v0[2], v0[3]); w1.x = cvt_pk_bf16(v1[0], v1[1]); w1.y = cvt_pk_bf16(v1[2], v1[3]);
                        *(u32x2*)(rowp + bj * 128) = w0; *(u32x2*)(rowp + bj * 128 + 8) = w1; } }
        }
    }
};
struct GridSched {
    const char* A; const char* B; int nM, nN, nP; size_t aTile, bTile, aBatch, bBatch; int G, c;
    __device__ bool next(int i, pg8::Unit& u) const {
        const int L = i * G + c; if (L >= nM * nN * nP) return false;
        const int p = L / (nM * nN), r = L % (nM * nN); u.pm = r / nN; u.pn = r % nN; u.kind = p;
        u.pa = A + (size_t)p * aBatch + (size_t)u.pm * aTile; u.pb = B + (size_t)p * bBatch + (size_t)u.pn * bTile; return true;
    }
};
struct Bf16Epi {
    bf16_t* O; int ldc, batchCols; float scale;
    __device__ __forceinline__ void operator()(const pg8::Acc& acc, const pg8::Unit& u, int wr, int wc, int fr, int fq) const {
        pg8::store_bf16_tile(acc, O + (size_t)u.pm * 256 * ldc + u.kind * batchCols + u.pn * 256, ldc, scale, wr, wc, fr, fq);
    }
};
struct ResF32Epi {
    float* H; const float* res;
    __device__ __forceinline__ void operator()(const pg8::Acc& acc, const pg8::Unit& u, int wr, int wc, int fr, int fq) const {
#pragma unroll
        for (int ai = 0; ai < 2; ++ai)
#pragma unroll
            for (int m = 0; m < 4; ++m) { const size_t o = (size_t)(u.pm * 256 + ai * 128 + wr * 64 + m * 16 + fr) * 2048 + u.pn * 256 + wc * 32 + 8 * fq;
#pragma unroll
                for (int bj = 0; bj < 2; ++bj) {
                    const f32x4 r0 = *(const f32x4*)(res + o + bj * 128), r1 = *(const f32x4*)(res + o + bj * 128 + 4);
                    *(f32x4*)(H + o + bj * 128) = r0 * ALPHA + acc[ai][bj][m][0]; *(f32x4*)(H + o + bj * 128 + 4) = r1 * ALPHA + acc[ai][bj][m][1]; } }
    }
};
struct MoeSched {
    const char* A; const char* B; const unsigned* ctl; int nN; size_t aTile, bTile; int G, c;
    __device__ bool next(int i, pg8::Unit& u) const {
        const int nt = (int)__hip_atomic_load(ctl + CW_NT, __ATOMIC_RELAXED, __HIP_MEMORY_SCOPE_AGENT); const int L = i * G + c; if (L >= nt * nN) return false;
        u.pm = L / nN; u.pn = L % nN; u.kind = (int)__hip_atomic_load(ctl + CW_TEXP + u.pm, __ATOMIC_RELAXED, __HIP_MEMORY_SCOPE_AGENT);
        u.pa = A + (size_t)u.pm * aTile; u.pb = B + (size_t)(u.kind * nN + u.pn) * bTile; return true;
    }
};
struct GateUpEpi {
    bf16_t* act; const float* sgw;
    __device__ __forceinline__ void operator()(const pg8::Acc& acc, const pg8::Unit& u, int wr, int wc, int fr, int fq) const {
#pragma unroll
        for (int ai = 0; ai < 2; ++ai)
#pragma unroll
            for (int m = 0; m < 4; ++m) { const int slot = u.pm * 256 + ai * 128 + wr * 64 + m * 16 + fr; const float gw = sgw[slot];
                float o[8];
#pragma unroll
                for (int n = 0; n < 2; ++n)
#pragma unroll
                    for (int e = 0; e < 4; ++e) { const float gt = acc[ai][0][m][n][e], up = acc[ai][1][m][n][e];
                        o[n * 4 + e] = gt / (1.0f + __expf(-gt)) * up * gw; }
                u32x4 w; w.x = cvt_pk_bf16(o[0], o[1]); w.y = cvt_pk_bf16(o[2], o[3]); w.z = cvt_pk_bf16(o[4], o[5]); w.w = cvt_pk_bf16(o[6], o[7]);
                *(u32x4*)(act + (size_t)slot * 512 + u.pn * 128 + wc * 32 + 8 * fq) = w; }
    }
};
struct DownEpi {
    bf16_t* dn;
    __device__ __forceinline__ void operator()(const pg8::Acc& acc, const pg8::Unit& u, int wr, int wc, int fr, int fq) const {
        pg8::store_bf16_tile(acc, dn + (size_t)u.pm * 256 * 2048 + u.pn * 256, 2048, 1.0f, wr, wc, fr, fq);
    }
};

__device__ __forceinline__ void cvt_T(LAS float* tile, const float* src, int ldsrc, int col0, int ncols, int K, bf16_t* dst, int& tbase, int bid, int nb, int tid) {
    const int ntk = K >> 6, ntn = (ncols + 63) >> 6, count = ntk * ntn;
    int g = tbase + (((bid - tbase) % nb) + nb) % nb;
    const int gend = tbase + count; tbase = gend;
    float v[8];
    if (g < gend) { const int t = g - (gend - count), tn = t / ntk, tk = t % ntk;
#pragma unroll
        for (int i = 0; i < 8; ++i) { const int idx = tid + NTHR * i, kk = idx >> 6, n = tn * 64 + (idx & 63);
            v[i] = (n < ncols) ? src[(size_t)(tk * 64 + kk) * ldsrc + col0 + n] : 0.f; } }
    for (; g < gend; g += nb) {
        const int t = g - (gend - count), tn = t / ntk, tk = t % ntk;
#pragma unroll
        for (int i = 0; i < 8; ++i) { const int idx = tid + NTHR * i; tile[(idx >> 6) * 65 + (idx & 63)] = v[i]; }
        __syncthreads();
        if (g + nb < gend) { const int t2 = g + nb - (gend - count), tn2 = t2 / ntk, tk2 = t2 % ntk;
#pragma unroll
            for (int i = 0; i < 8; ++i) { const int idx = tid + NTHR * i, kk = idx >> 6, n = tn2 * 64 + (idx & 63);
                v[i] = (n < ncols) ? src[(size_t)(tk2 * 64 + kk) * ldsrc + col0 + n] : 0.f; } }
#pragma unroll
        for (int i = 0; i < 4; ++i) { const int p = tid + NTHR * i, nn = p >> 5, kp = p & 31, n = tn * 64 + nn;
            if (n < ncols) *(unsigned*)(dst + (size_t)n * K + tk * 64 + 2 * kp) = cvt_pk_bf16(tile[(2 * kp) * 65 + nn], tile[(2 * kp + 1) * 65 + nn]); }
        __syncthreads();
    }
}
__device__ __forceinline__ void p0_common(const Params& P, unsigned char* ws, int bid, int nb, int tid) {
    const int gtid = bid * NTHR + tid, gn = nb * NTHR;
    { bf16_t* xb = (bf16_t*)(ws + WS_Z);
      for (size_t i = gtid; i < (size_t)SEQ * DM / 8; i += gn) { const f32x4 a = *(const f32x4*)(P.x + i * 8), b = *(const f32x4*)(P.x + i * 8 + 4);
          u32x4 w; w.x = cvt_pk_bf16(a[0], a[1]); w.y = cvt_pk_bf16(a[2], a[3]); w.z = cvt_pk_bf16(b[0], b[1]); w.w = cvt_pk_bf16(b[2], b[3]); *(u32x4*)(xb + i * 8) = w; } }
    { f32x2* rot = (f32x2*)(ws + WS_ROT);
      for (int i = gtid; i < SEQ * 64; i += gn) { const int t = i >> 6, f = i & 63;
          const float theta = exp2f(-((float)f / 63.0f) * 13.287712379549449f); const float ang = (float)t * theta;
          double r = (double)ang * 0.15915494309189535; r -= floor(r); const float rf = (float)r;
          rot[i] = (f32x2){__builtin_amdgcn_cosf(rf), __builtin_amdgcn_sinf(rf)}; } }
}
__device__ __forceinline__ void p0_weights(const Params& P, unsigned char* ws, LAS unsigned char* lds, int l, int bid, int nb, int tid) {
    LAS float* tile = (LAS float*)lds;
    const int gtid = bid * NTHR + tid, gn = nb * NTHR;
    {
        const float* wkv = P.w_kv_up + (size_t)l * 256 * 1536;
        bf16_t* wabs = (bf16_t*)(ws + WS_WABS); bf16_t* wuvp = (bf16_t*)(ws + WS_WUVP);
        for (int i = gtid; i < 3 * 512 * 256; i += gn) { const int k = i & 255, row = (i >> 8) & 511, p = i >> 17, hh = row >> 8, r = row & 255;
            const float v = ((k >> 7) == hh) ? wkv[(size_t)r * 1536 + (2 * p + hh) * 256 + (k & 127)] : 0.f; wabs[i] = (bf16_t)(cvt_pk_bf16(v, 0.f) & 0xffffu); }
        for (int i = gtid; i < 3 * 256 * 512; i += gn) { const int k = i & 511, row = (i >> 9) & 255, p = i >> 17, hh = row >> 7, e = row & 127;
            const float v = ((k >> 8) == hh) ? wkv[(size_t)(k & 255) * 1536 + (2 * p + hh) * 256 + 128 + e] : 0.f; wuvp[i] = (bf16_t)(cvt_pk_bf16(v, 0.f) & 0xffffu); }
        { bf16_t* wt = (bf16_t*)(ws + WS_Z) + (size_t)8192 * 2048;
          for (int i = gtid; i < 184 * 2048 / 8; i += gn) *(u32x4*)(wt + (size_t)5192 * 2048 + (size_t)i * 8) = (u32x4){0u, 0u, 0u, 0u}; }
    }
    int tb = 0;
    {
        bf16_t* wt = (bf16_t*)(ws + WS_Z) + (size_t)8192 * 2048;
        const float* win = P.w_in + (size_t)l * 2048 * DIN;
        cvt_T(tile, win, DIN, 0, 1536, 2048, wt, tb, bid, nb, tid);
        cvt_T(tile, win, DIN, 2304, 3656, 2048, wt + (size_t)1536 * 2048, tb, bid, nb, tid);
        cvt_T(tile, win, DIN, 1536, 768, 2048, wt + (size_t)5376 * 2048, tb, bid, nb, tid);
        cvt_T(tile, P.w_o + (size_t)l * 2048 * 2048, 2048, 0, 2048, 2048, (bf16_t*)(ws + WS_WOT), tb, bid, nb, tid);
        for (int e = 0; e < 16; ++e) {
            const float* wg = P.w_gate + ((size_t)l * 16 + e) * 2048 * 512; const float* wu = P.w_up + ((size_t)l * 16 + e) * 2048 * 512;
            bf16_t* d = (bf16_t*)(ws + WS_WGU) + (size_t)e * 1024 * 2048;
            for (int pn = 0; pn < 4; ++pn) {
                cvt_T(tile, wg, 512, pn * 128, 128, 2048, d + (size_t)(pn * 256) * 2048, tb, bid, nb, tid);
                cvt_T(tile, wu, 512, pn * 128, 128, 2048, d + (size_t)(pn * 256 + 128) * 2048, tb, bid, nb, tid);
            }
            cvt_T(tile, P.w_down + ((size_t)l * 16 + e) * 512 * 2048, 2048, 0, 2048, 512, (bf16_t*)(ws + WS_WDT) + (size_t)e * 2048 * 512, tb, bid, nb, tid);
        }
    }
}

constexpr int SB_KROW = 272, SB_VROW = 144;
constexpr int SB_KBUF = 64 * SB_KROW, SB_VBUF = 128 * SB_VROW;
__device__ __forceinline__ void sb_attn_phase(LAS unsigned char* lds, const bf16_t* __restrict__ Q, const bf16_t* __restrict__ Kg, const bf16_t* __restrict__ Vt, bf16_t* __restrict__ Y,
                              int ubase, int bid, int nb, int tid) {
    const int wid = __builtin_amdgcn_readfirstlane(tid >> 6), lane = tid & 63, ln = lane & 31, hl = lane >> 5;
    const int first = ubase + (((bid - ubase) % nb) + nb) % nb;
    for (int ug = first; ug < ubase + 192; ug += nb) {
        const int u = ug - ubase, qb = 31 - u / 6, h = u % 6;
        const int t0 = qb * 256, tw0 = t0 + 32 * wid, tq = tw0 + ln, twmax = tw0 + 31;
        const int nkt = 4 * qb + 4;
        bf16x8 bq[8];
#pragma unroll
        for (int s = 0; s < 8; ++s) bq[s] = *(const bf16x8*)(Q + (size_t)tq * 768 + h * 128 + 16 * s + 8 * hl);
        f32x16 O[4];
#pragma unroll
        for (int c = 0; c < 4; ++c)
#pragma unroll
            for (int i = 0; i < 16; ++i) O[c][i] = 0.f;
        float R = 0.f;
        u32x4 sk[2], sv[2];
        auto gload = [&](int kt) {
#pragma unroll
            for (int i = 0; i < 2; ++i) { const int c = tid + NTHR * i;
                sk[i] = *(const u32x4*)(Kg + (size_t)(kt * 64 + (c >> 4)) * 768 + h * 128 + (c & 15) * 8);
                sv[i] = *(const u32x4*)(Vt + (size_t)(h * 128 + (c >> 3)) * SEQ + kt * 64 + (c & 7) * 8); }
        };
        auto lstore = [&](int buf) {
#pragma unroll
            for (int i = 0; i < 2; ++i) { const int c = tid + NTHR * i;
                *(LAS u32x4*)(lds + buf * SB_KBUF + (c >> 4) * SB_KROW + (c & 15) * 16) = sk[i];
                *(LAS u32x4*)(lds + 2 * SB_KBUF + buf * SB_VBUF + (c >> 3) * SB_VROW + (c & 7) * 16) = sv[i]; }
        };
        gload(nkt - 1); lstore(0); __syncthreads();
        LAS int* flags = (LAS int*)(lds + 2 * SB_KBUF + 2 * SB_VBUF);
        for (int kt = nkt - 1; kt >= 0; --kt) {
            const int cur = (nkt - 1 - kt) & 1;
            if (kt > 0) gload(kt - 1);
            if (kt * 64 < twmax) {
                LAS unsigned char* kb = lds + cur * SB_KBUF; LAS unsigned char* vb = lds + 2 * SB_KBUF + cur * SB_VBUF;
#pragma unroll
                for (int uu = 1; uu >= 0; --uu) {
                    const int key0 = kt * 64 + 32 * uu;
                    if (key0 < twmax) {
                        f32x16 Sx;
#pragma unroll
                        for (int i = 0; i < 16; ++i) Sx[i] = 0.f;
#pragma unroll
                        for (int s = 0; s < 8; ++s) { const bf16x8 a = *(const LAS bf16x8*)(kb + (32 * uu + ln) * SB_KROW + (16 * s + 8 * hl) * 2); Sx = mfma32(a, bq[s], Sx); }
                        const bool need_mask = (key0 + 31 >= tw0);
                        float lr[16];
#pragma unroll
                        for (int i = 0; i < 16; ++i) {
                            float z = Sx[i];
                            if (need_mask) { const int key = key0 + (i & 3) + 8 * (i >> 2) + 4 * hl; z = (key < tq) ? z : -1e30f; }
                            const float sp = fmaxf(z, 0.f) + __builtin_amdgcn_logf(1.0f + __builtin_amdgcn_exp2f(-fabsf(z)));
                            lr[i] = -sp; Sx[i] = z;
                        }
                        float T[4], PT[4];
#pragma unroll
                        for (int g = 0; g < 4; ++g) { T[g] = (lr[4 * g] + lr[4 * g + 1]) + (lr[4 * g + 2] + lr[4 * g + 3]); PT[g] = __shfl_xor(T[g], 32); }
                        const float W0 = T[0] + PT[0], W1 = T[1] + PT[1], W2 = T[2] + PT[2], W3 = T[3] + PT[3];
                        float Ag[4]; Ag[3] = R; Ag[2] = R + W3; Ag[1] = Ag[2] + W2; Ag[0] = Ag[1] + W1;
                        R = Ag[0] + W0;
                        float pv[16];
#pragma unroll
                        for (int g = 0; g < 4; ++g) {
                            const float base = Ag[g] + (hl == 0 ? PT[g] : 0.f);
                            const float a3 = base, a2 = a3 + lr[4 * g + 3], a1 = a2 + lr[4 * g + 2], a0 = a1 + lr[4 * g + 1];
                            pv[4 * g + 3] = __builtin_amdgcn_exp2f(Sx[4 * g + 3] + lr[4 * g + 3] + a3);
                            pv[4 * g + 2] = __builtin_amdgcn_exp2f(Sx[4 * g + 2] + lr[4 * g + 2] + a2);
                            pv[4 * g + 1] = __builtin_amdgcn_exp2f(Sx[4 * g + 1] + lr[4 * g + 1] + a1);
                            pv[4 * g + 0] = __builtin_amdgcn_exp2f(Sx[4 * g + 0] + lr[4 * g + 0] + a0);
                        }
                        bf16x8 pb[2];
#pragma unroll
                        for (int s2 = 0; s2 < 2; ++s2) { u32x4 w; w.x = cvt_pk_bf16(pv[8 * s2], pv[8 * s2 + 1]); w.y = cvt_pk_bf16(pv[8 * s2 + 2], pv[8 * s2 + 3]);
                            w.z = cvt_pk_bf16(pv[8 * s2 + 4], pv[8 * s2 + 5]); w.w = cvt_pk_bf16(pv[8 * s2 + 6], pv[8 * s2 + 7]); pb[s2] = as_bf16x8(w); }
#pragma unroll
                        for (int c = 0; c < 4; ++c)
#pragma unroll
                            for (int s2 = 0; s2 < 2; ++s2) { const bf16x8 a = *(const LAS bf16x8*)(vb + (32 * c + ln) * SB_VROW + (32 * uu + 16 * s2 + 8 * hl) * 2); O[c] = mfma32(a, pb[s2], O[c]); }
                    }
                }
            }
            if (kt > 0) lstore(cur ^ 1);
            { const bool started = (kt * 64 < twmax); const int dn = (started && __all(R < -40.0f)) ? 1 : 0; if (lane == 0) flags[cur * 8 + wid] = dn; }
            __syncthreads();
            { int all = 1;
#pragma unroll
              for (int w = 0; w < 8; ++w) all &= flags[cur * 8 + w];
              if (all) break; }
        }
#pragma unroll
        for (int c = 0; c < 4; ++c)
#pragma unroll
            for (int g = 0; g < 4; ++g) { u32x2 w; w.x = cvt_pk_bf16(O[c][4 * g], O[c][4 * g + 1]); w.y = cvt_pk_bf16(O[c][4 * g + 2], O[c][4 * g + 3]);
                *(u32x2*)(Y + (size_t)tq * 2048 + h * 128 + 32 * c + 8 * g + 4 * hl) = w; }
    }
}

__constant__ float RET_L2G[4] = {-0.045803689613124735f, -0.022720076500083467f, -0.011315313227834146f, -0.0056465631411421125f};
constexpr int RT_ROW = 272;
constexpr int RT_TILE = 128 * RT_ROW;
__device__ __forceinline__ void rot8(const u32x4 a, const u32x4 b, const f32x2* __restrict__ cs, float sc, float (&o1)[8], float (&o2)[8]) {
#pragma unroll
    for (int j = 0; j < 4; ++j) {
        const float x1l = bflo(a[j]), x1h = bfhi(a[j]), x2l = bflo(b[j]), x2h = bfhi(b[j]);
        const f32x2 c0 = cs[2 * j], c1 = cs[2 * j + 1];
        o1[2 * j] = (x1l * c0.x - x2l * c0.y) * sc; o2[2 * j] = (x1l * c0.y + x2l * c0.x) * sc;
        o1[2 * j + 1] = (x1h * c1.x - x2h * c1.y) * sc; o2[2 * j + 1] = (x1h * c1.y + x2h * c1.x) * sc;
    }
}
__device__ __forceinline__ void ret_kv_phase(LAS unsigned char* lds, const bf16_t* __restrict__ Kr, const bf16_t* __restrict__ Vr, const f32x2* __restrict__ rot, float* __restrict__ KVT,
                             int ubase, int bid, int nb, int tid) {
    const int wid = __builtin_amdgcn_readfirstlane(tid >> 6), lane = tid & 63, ln = lane & 31, hl = lane >> 5;
    LAS unsigned char* vt = lds; LAS unsigned char* kt = lds + RT_TILE;
    const int first = ubase + (((bid - ubase) % nb) + nb) % nb;
    for (int ug = first; ug < ubase + 256; ug += nb) {
        const int u = ug - ubase, h = u >> 6, c = u & 63, j0 = c * 128;
        const float l2g = RET_L2G[h];
#pragma unroll
        for (int i = 0; i < 2; ++i) { const int it = tid + NTHR * i, j = it & 127, dg = it >> 7;
            const u32x4 a = *(const u32x4*)(Kr + (size_t)(j0 + j) * 512 + h * 128 + 8 * dg), b = *(const u32x4*)(Kr + (size_t)(j0 + j) * 512 + h * 128 + 64 + 8 * dg);
            float o1[8], o2[8]; rot8(a, b, rot + (size_t)(j0 + j) * 64 + 8 * dg, 0.08838834764831845f * __builtin_amdgcn_exp2f((float)(127 - j) * l2g), o1, o2);
#pragma unroll
            for (int e = 0; e < 8; e += 2) { const unsigned p1 = cvt_pk_bf16(o1[e], o1[e + 1]), p2 = cvt_pk_bf16(o2[e], o2[e + 1]);
                *(LAS bf16_t*)(kt + (8 * dg + e) * RT_ROW + j * 2) = (bf16_t)(p1 & 0xffffu); *(LAS bf16_t*)(kt + (8 * dg + e + 1) * RT_ROW + j * 2) = (bf16_t)(p1 >> 16);
                *(LAS bf16_t*)(kt + (64 + 8 * dg + e) * RT_ROW + j * 2) = (bf16_t)(p2 & 0xffffu); *(LAS bf16_t*)(kt + (64 + 8 * dg + e + 1) * RT_ROW + j * 2) = (bf16_t)(p2 >> 16); } }
#pragma unroll
        for (int i = 0; i < 4; ++i) { const int it = tid + NTHR * i, j = it & 127, ch = it >> 7;
            const u32x4 a = *(const u32x4*)(Vr + (size_t)(j0 + j) * 512 + h * 128 + 8 * ch);
#pragma unroll
            for (int e = 0; e < 4; ++e) { *(LAS bf16_t*)(vt + (8 * ch + 2 * e) * RT_ROW + j * 2) = (bf16_t)(a[e] & 0xffffu); *(LAS bf16_t*)(vt + (8 * ch + 2 * e + 1) * RT_ROW + j * 2) = (bf16_t)(a[e] >> 16); } }
        __syncthreads();
        const int ce = wid & 3, dh = wid >> 2;
        f32x16 acc[2];
#pragma unroll
        for (int n = 0; n < 2; ++n)
#pragma unroll
            for (int i = 0; i < 16; ++i) acc[n][i] = 0.f;
#pragma unroll
        for (int s = 0; s < 8; ++s) {
            const bf16x8 a = *(const LAS bf16x8*)(vt + (32 * ce + ln) * RT_ROW + (16 * s + 8 * hl) * 2);
#pragma unroll
            for (int n = 0; n < 2; ++n) { const bf16x8 b = *(const LAS bf16x8*)(kt + (64 * dh + 32 * n + ln) * RT_ROW + (16 * s + 8 * hl) * 2); acc[n] = mfma32(a, b, acc[n]); }
        }
        float* out = KVT + (size_t)u * 16384;
#pragma unroll
        for (int n = 0; n < 2; ++n)
#pragma unroll
            for (int i = 0; i < 16; ++i) out[(32 * ce + (i & 3) + 8 * (i >> 2) + 4 * hl) * 128 + 64 * dh + 32 * n + ln] = acc[n][i];
        __syncthreads();
    }
}
__device__ __forceinline__ void ret_scan_phase(const float* __restrict__ KVT, bf16_t* __restrict__ ST, int bid, int nb, int tid) {
    for (int idx = bid * NTHR + tid; idx < 65536; idx += nb * NTHR) {
        const int h = idx >> 14, ed = idx & 16383; const float cd = __builtin_amdgcn_exp2f(128.0f * RET_L2G[h]);
        float s = 0.f;
        for (int c0 = 0; c0 < 64; c0 += 8) {
            float kv[8];
#pragma unroll
            for (int k = 0; k < 8; ++k) kv[k] = KVT[((size_t)(h * 64 + c0 + k)) * 16384 + ed];
#pragma unroll
            for (int k = 0; k < 8; ++k) { ST[((size_t)(h * 64 + c0 + k)) * 16384 + ed] = (bf16_t)(cvt_pk_bf16(s, 0.f) & 0xffffu); s = s * cd + kv[k]; }
        }
    }
}
__device__ __forceinline__ void ret_out_phase(LAS unsigned char* lds, const bf16_t* __restrict__ Qr, const bf16_t* __restrict__ Kr, const bf16_t* __restrict__ Vr, const bf16_t* __restrict__ Gr,
                              const f32x2* __restrict__ rot, const bf16_t* __restrict__ ST, const float* __restrict__ gng, bf16_t* __restrict__ Y,
                              int ubase, int bid, int nb, int tid) {
    const int wid = __builtin_amdgcn_readfirstlane(tid >> 6), lane = tid & 63, ln = lane & 31, hl = lane >> 5;
    LAS unsigned char* kp = lds; LAS unsigned char* vt = lds + RT_TILE;
    const int first = ubase + (((bid - ubase) % nb) + nb) % nb;
    for (int ug = first; ug < ubase + 256; ug += nb) {
        const int u = ug - ubase, h = u >> 6, c = u & 63, j0 = c * 128;
        const float l2g = RET_L2G[h];
#pragma unroll
        for (int i = 0; i < 2; ++i) { const int it = tid + NTHR * i, dg = it & 7, j = it >> 3;
            const u32x4 a = *(const u32x4*)(Kr + (size_t)(j0 + j) * 512 + h * 128 + 8 * dg), b = *(const u32x4*)(Kr + (size_t)(j0 + j) * 512 + h * 128 + 64 + 8 * dg);
            float o1[8], o2[8]; rot8(a, b, rot + (size_t)(j0 + j) * 64 + 8 * dg, 0.08838834764831845f, o1, o2);
            u32x4 w1, w2; w1.x = cvt_pk_bf16(o1[0], o1[1]); w1.y = cvt_pk_bf16(o1[2], o1[3]); w1.z = cvt_pk_bf16(o1[4], o1[5]); w1.w = cvt_pk_bf16(o1[6], o1[7]);
            w2.x = cvt_pk_bf16(o2[0], o2[1]); w2.y = cvt_pk_bf16(o2[2], o2[3]); w2.z = cvt_pk_bf16(o2[4], o2[5]); w2.w = cvt_pk_bf16(o2[6], o2[7]);
            *(LAS u32x4*)(kp + j * RT_ROW + 16 * dg) = w1; *(LAS u32x4*)(kp + j * RT_ROW + 128 + 16 * dg) = w2; }
#pragma unroll
        for (int i = 0; i < 4; ++i) { const int it = tid + NTHR * i, j = it & 127, ch = it >> 7;
            const int pos = (j & ~15) | ((j & 3) + 4 * ((j >> 3) & 1) + 8 * ((j >> 2) & 1));
            const u32x4 a = *(const u32x4*)(Vr + (size_t)(j0 + j) * 512 + h * 128 + 8 * ch);
#pragma unroll
            for (int e = 0; e < 4; ++e) { *(LAS bf16_t*)(vt + (8 * ch + 2 * e) * RT_ROW + pos * 2) = (bf16_t)(a[e] & 0xffffu); *(LAS bf16_t*)(vt + (8 * ch + 2 * e + 1) * RT_ROW + pos * 2) = (bf16_t)(a[e] >> 16); } }
        __syncthreads();
        if (wid < 4) {
            const int il = 32 * wid + ln, tq = j0 + il;
            bf16x8 bq[8];
#pragma unroll
            for (int s = 0; s < 4; ++s) {
                const u32x4 a = *(const u32x4*)(Qr + (size_t)tq * 512 + h * 128 + 16 * s + 8 * hl), b = *(const u32x4*)(Qr + (size_t)tq * 512 + h * 128 + 64 + 16 * s + 8 * hl);
                float o1[8], o2[8]; rot8(a, b, rot + (size_t)tq * 64 + 16 * s + 8 * hl, 1.0f, o1, o2);
                u32x4 w1, w2; w1.x = cvt_pk_bf16(o1[0], o1[1]); w1.y = cvt_pk_bf16(o1[2], o1[3]); w1.z = cvt_pk_bf16(o1[4], o1[5]); w1.w = cvt_pk_bf16(o1[6], o1[7]);
                w2.x = cvt_pk_bf16(o2[0], o2[1]); w2.y = cvt_pk_bf16(o2[2], o2[3]); w2.z = cvt_pk_bf16(o2[4], o2[5]); w2.w = cvt_pk_bf16(o2[6], o2[7]);
                bq[s] = as_bf16x8(w1); bq[s + 4] = as_bf16x8(w2);
            }
            f32x16 O[4];
#pragma unroll
            for (int ce = 0; ce < 4; ++ce)
#pragma unroll
                for (int i = 0; i < 16; ++i) O[ce][i] = 0.f;
            const bf16_t* st = ST + (size_t)u * 16384;
#pragma unroll
            for (int ce = 0; ce < 4; ++ce)
#pragma unroll
                for (int s = 0; s < 8; ++s) { const bf16x8 a = *(const bf16x8*)(st + (size_t)(32 * ce + ln) * 128 + 16 * s + 8 * hl); O[ce] = mfma32(a, bq[s], O[ce]); }
            const float qd = __builtin_amdgcn_exp2f((float)(il + 1) * l2g);
#pragma unroll
            for (int ce = 0; ce < 4; ++ce)
#pragma unroll
                for (int i = 0; i < 16; ++i) O[ce][i] *= qd;
            for (int jb = 0; jb <= wid; ++jb) {
                f32x16 Sx;
#pragma unroll
                for (int i = 0; i < 16; ++i) Sx[i] = 0.f;
#pragma unroll
                for (int s = 0; s < 8; ++s) { const bf16x8 a = *(const LAS bf16x8*)(kp + (32 * jb + ln) * RT_ROW + (16 * s + 8 * hl) * 2); Sx = mfma32(a, bq[s], Sx); }
                float pv[16];
#pragma unroll
                for (int i = 0; i < 16; ++i) { const int jl = 32 * jb + (i & 3) + 8 * (i >> 2) + 4 * hl; const int diff = il - jl;
                    pv[i] = (diff >= 0) ? Sx[i] * __builtin_amdgcn_exp2f((float)diff * l2g) : 0.f; }
                bf16x8 pb[2];
#pragma unroll
                for (int s2 = 0; s2 < 2; ++s2) { u32x4 w; w.x = cvt_pk_bf16(pv[8 * s2], pv[8 * s2 + 1]); w.y = cvt_pk_bf16(pv[8 * s2 + 2], pv[8 * s2 + 3]);
                    w.z = cvt_pk_bf16(pv[8 * s2 + 4], pv[8 * s2 + 5]); w.w = cvt_pk_bf16(pv[8 * s2 + 6], pv[8 * s2 + 7]); pb[s2] = as_bf16x8(w); }
#pragma unroll
                for (int ce = 0; ce < 4; ++ce)
#pragma unroll
                    for (int s2 = 0; s2 < 2; ++s2) { const bf16x8 a = *(const LAS bf16x8*)(vt + (32 * ce + ln) * RT_ROW + (32 * jb + 16 * s2 + 8 * hl) * 2); O[ce] = mfma32(a, pb[s2], O[ce]); }
            }
            float sm = 0.f;
#pragma unroll
            for (int ce = 0; ce < 4; ++ce)
#pragma unroll
                for (int i = 0; i < 16; ++i) sm += O[ce][i];
            sm += __shfl_xor(sm, 32);
            const float mu = sm * (1.0f / 128.0f);
            float sq = 0.f;
#pragma unroll
            for (int ce = 0; ce < 4; ++ce)
#pragma unroll
                for (int i = 0; i < 16; ++i) { const float d = O[ce][i] - mu; sq += d * d; }
            sq += __shfl_xor(sq, 32);
            const float rstd = __builtin_amdgcn_rsqf(sq * (1.0f / 128.0f) + 1e-6f);
#pragma unroll
            for (int ce = 0; ce < 4; ++ce)
#pragma unroll
                for (int g = 0; g < 4; ++g) {
                    const int e0 = 32 * ce + 8 * g + 4 * hl;
                    const u32x2 gv = *(const u32x2*)(Gr + (size_t)tq * 512 + h * 128 + e0); const f32x4 gn = *(const f32x4*)(gng + h * 128 + e0);
                    float gg[4] = {bflo(gv.x), bfhi(gv.x), bflo(gv.y), bfhi(gv.y)}; float o[4];
#pragma unroll
                    for (int e = 0; e < 4; ++e) { const float y = (O[ce][4 * g + e] - mu) * rstd * gn[e]; o[e] = y * gg[e] / (1.0f + __expf(-gg[e])); }
                    u32x2 w; w.x = cvt_pk_bf16(o[0], o[1]); w.y = cvt_pk_bf16(o[2], o[3]);
                    *(u32x2*)(Y + (size_t)tq * 2048 + 768 + h * 128 + e0) = w;
                }
        }
        __syncthreads();
    }
}

#ifndef REP_PHASE
#define REP_PHASE -1
#endif
__device__ __forceinline__ void cn_phase(const bf16_t* __restrict__ CKV, const float* __restrict__ g, bf16_t* __restrict__ CN, int bid, int nb, int tid) {
    const int wid = tid >> 6, lane = tid & 63;
    const f32x4 gv = *(const f32x4*)(g + 4 * lane);
    for (int t = bid * 8 + wid; t < SEQ; t += nb * 8) {
        const u32x2 vv = *(const u32x2*)(CKV + (size_t)t * 256 + 4 * lane); const f32x4 v = (f32x4){bflo(vv.x), bfhi(vv.x), bflo(vv.y), bfhi(vv.y)};
        const float ss = wave_sum(v[0] * v[0] + v[1] * v[1] + v[2] * v[2] + v[3] * v[3]);
        const float rs = __builtin_amdgcn_rsqf(ss * (1.0f / 256.0f) + 1e-6f);
        u32x2 w; w.x = cvt_pk_bf16(v[0] * rs * gv[0], v[1] * rs * gv[1]); w.y = cvt_pk_bf16(v[2] * rs * gv[2], v[3] * rs * gv[3]);
        *(u32x2*)(CN + (size_t)t * 256 + 4 * lane) = w;
    }
}
__device__ __forceinline__ void score_phase(const bf16_t* __restrict__ Qi, const bf16_t* __restrict__ KW, float* __restrict__ SC, int vbase, int bid, int nb, int tid) {
    const int wid = tid >> 6, lane = tid & 63, ln = lane & 31, hl = lane >> 5;
    const int nw = nb * 8, NV = 8320;
    int v = vbase + ((((bid * 8 + wid) - vbase) % nw) + nw) % nw;
    for (; v < vbase + NV; v += nw) {
        const int vv = v - vbase, tri = vv >> 2, sub = vv & 3;
        int q4 = (int)((__builtin_sqrtf(8.0f * (float)tri + 1.0f) - 1.0f) * 0.5f);
        while ((q4 + 1) * (q4 + 2) / 2 <= tri) ++q4;
        while (q4 * (q4 + 1) / 2 > tri) --q4;
        const int kt = tri - q4 * (q4 + 1) / 2, qblk = 4 * q4 + sub, tq = 32 * qblk + ln, kbase = 128 * kt;
        bf16x8 ka[4][4];
#pragma unroll
        for (int uu = 0; uu < 4; ++uu)
#pragma unroll
            for (int s = 0; s < 4; ++s) ka[uu][s] = *(const bf16x8*)(KW + (size_t)(kbase + 32 * uu + ln) * 256 + 16 * s + 8 * hl);
        bf16x8 qb[2][4];
#pragma unroll
        for (int hh = 0; hh < 2; ++hh)
#pragma unroll
            for (int s = 0; s < 4; ++s) qb[hh][s] = *(const bf16x8*)(Qi + (size_t)tq * 512 + hh * 64 + 16 * s + 8 * hl);
        f32x16 sc[4];
#pragma unroll
        for (int uu = 0; uu < 4; ++uu)
#pragma unroll
            for (int i = 0; i < 16; ++i) sc[uu][i] = 0.f;
#pragma unroll 1
        for (int hp = 0; hp < 4; ++hp) {
            bf16x8 qn[2][4];
            const int hpn = hp < 3 ? hp + 1 : 3;
#pragma unroll
            for (int hh = 0; hh < 2; ++hh)
#pragma unroll
                for (int s = 0; s < 4; ++s) qn[hh][s] = *(const bf16x8*)(Qi + (size_t)tq * 512 + (2 * hpn + hh) * 64 + 16 * s + 8 * hl);
            const unsigned wpk = *(const unsigned*)(KW + (size_t)tq * 256 + 64 + 2 * hp); const float wa = bflo(wpk) * IDX_SCALE, wb = bfhi(wpk) * IDX_SCALE;
#pragma unroll
            for (int uu = 0; uu < 4; ++uu)
#pragma unroll
                for (int hh = 0; hh < 2; ++hh) {
                    f32x16 t;
#pragma unroll
                    for (int i = 0; i < 16; ++i) t[i] = 0.f;
#pragma unroll
                    for (int s = 0; s < 4; ++s) t = mfma32(ka[uu][s], qb[hh][s], t);
                    const float w = hh ? wb : wa;
#pragma unroll
                    for (int i = 0; i < 16; ++i) sc[uu][i] += w * fmaxf(t[i], 0.f);
                }
#pragma unroll
            for (int hh = 0; hh < 2; ++hh)
#pragma unroll
                for (int s = 0; s < 4; ++s) qb[hh][s] = qn[hh][s];
        }
#pragma unroll
        for (int uu = 0; uu < 4; ++uu)
#pragma unroll
            for (int g = 0; g < 4; ++g) { const int key0 = kbase + 32 * uu + 8 * g + 4 * hl;
                if (key0 <= (tq | 3)) *(f32x4*)(SC + sc_rowoff(tq) + key0) = (f32x4){sc[uu][4 * g], sc[uu][4 * g + 1], sc[uu][4 * g + 2], sc[uu][4 * g + 3]}; }
    }
}
constexpr int DS_ROW = 544;
constexpr int DS_TILE = 32 * DS_ROW;
__device__ __forceinline__ void dsa_phase(LAS unsigned char* lds, const float* __restrict__ SC, const bf16_t* __restrict__ CN, const bf16_t* __restrict__ QP, bf16_t* __restrict__ OP, int bid, int nb, int tid) {
    const int wid = __builtin_amdgcn_readfirstlane(tid >> 6), lane = tid & 63, hn = lane & 15, g = lane >> 4;
    LAS unsigned char* tile = lds + wid * DS_TILE;
    LAS unsigned short* list = (LAS unsigned short*)(lds + 8 * DS_TILE + wid * 512);
    const int gw = bid * 8 + wid, nw = nb * 8;
    for (int rr = gw; rr < SEQ; rr += nw) {
        const int blk = rr / nw, pos = rr % nw; const int t = (blk & 1) ? (blk * nw + (nw - 1 - pos)) : rr;
        const int n = t + 1; int nvalid;
        if (n <= 256) {
            nvalid = n;
#pragma unroll
            for (int i = 0; i < 4; ++i) { const int e = i * 64 + lane; list[e] = (unsigned short)(e < n ? e : t); }
        } else {
            nvalid = 256;
            const int nI = (n + 63) >> 6;
            unsigned key[128];
            const float* row = SC + sc_rowoff(t);
#pragma unroll
            for (int i = 0; i < 128; ++i) {
                unsigned k = 0u;
                if (i < nI) { const int e = i * 64 + lane; if (e < n) { const unsigned b = __float_as_uint(row[e]); k = (b & 0x80000000u) ? ~b : (b | 0x80000000u); } }
                key[i] = k;
            }
            LAS unsigned* hist = (LAS unsigned*)tile;
            unsigned prefix = 0u, pmask = 0u; int need = 256;
#if REP_PHASE == 221
            for (int rep_ = 0; rep_ < 2; ++rep_) { prefix = 0u; pmask = 0u; need = 256; asm volatile("" : "+s"(prefix));
#endif
#pragma unroll 1
            for (int pass = 0; pass < 3; ++pass) {
                const int shift = pass == 0 ? 21 : (pass == 1 ? 10 : 0), wl = pass == 2 ? 4 : 5;
                const unsigned dm = (64u << wl) - 1u;
#pragma unroll
                for (int j = 0; j < 33; ++j) hist[j * 64 + lane] = 0u;
#pragma unroll
                for (int i0 = 0; i0 < 128; i0 += 16) if (i0 < nI) {
#pragma unroll
                    for (int i = i0; i < i0 + 16; ++i) { const unsigned k = key[i];
                        if ((k & pmask) == prefix && k != 0u) { const unsigned bn = (k >> shift) & dm; __hip_atomic_fetch_add(hist + bn + (bn >> 5), 1u, __ATOMIC_RELAXED, __HIP_MEMORY_SCOPE_WORKGROUP); } }
                }
                unsigned hb[32]; unsigned tot = 0u;
#pragma unroll
                for (int j = 0; j < 32; ++j) { const unsigned bn = ((unsigned)lane << wl) + j; hb[j] = (j < (1 << wl)) ? hist[bn + (bn >> 5)] : 0u; tot += hb[j]; }
                unsigned suf = tot;
#pragma unroll
                for (int off = 1; off < 64; off <<= 1) { const unsigned v = __shfl_down(suf, off); suf += (lane + off < 64) ? v : 0u; }
                const unsigned long long mk = __ballot((int)suf >= need);
                const int L = 63 - __builtin_clzll(mk | 1ull);
                int acc = (int)(suf - tot), bsel = 0, above = 0; bool found = false;
#pragma unroll
                for (int j = 31; j >= 0; --j) { const int h2 = (int)hb[j]; const bool hit = !found && (j < (1 << wl)) && (acc + h2 >= need);
                    if (hit) { bsel = (lane << wl) + j; above = acc; found = true; } acc += h2; }
                const int bS = __builtin_amdgcn_readlane(bsel, L), aS = __builtin_amdgcn_readlane(above, L);
                need -= aS; prefix |= (unsigned)bS << shift; pmask |= dm << shift;
            }
#if REP_PHASE == 221
            }
#endif
            const unsigned T = prefix;
            int obase = 0, ebase = 0; const unsigned long long ltm = (1ull << lane) - 1ull;
#pragma unroll
            for (int i0 = 0; i0 < 128; i0 += 16) if (i0 < nI) {
#pragma unroll
                for (int i = i0; i < i0 + 16; ++i) {
                    const bool gt = key[i] > T, eq = key[i] == T;
                    const unsigned long long meq = __ballot(eq);
                    const bool selq = gt || (eq && (ebase + __popcll(meq & ltm) < need));
                    const unsigned long long ms = __ballot(selq);
                    if (selq) list[obase + __popcll(ms & ltm)] = (unsigned short)(i * 64 + lane);
                    obase += __popcll(ms); ebase += __popcll(meq);
                }
            }
        }
        bf16x8 bq[8];
#pragma unroll
        for (int s = 0; s < 8; ++s) { u32x4 v = (u32x4){0u, 0u, 0u, 0u}; if (hn < 6) v = *(const u32x4*)(QP + (size_t)t * 1536 + hn * 256 + 32 * s + 8 * g); bq[s] = as_bf16x8(v); }
        f32x4 O[16]; float mrun, lsum;
#if REP_PHASE == 222
        for (int rep_ = 0; rep_ < 2; ++rep_) {
#endif
#pragma unroll
        for (int c = 0; c < 16; ++c) O[c] = (f32x4){0.f, 0.f, 0.f, 0.f};
        mrun = -1e30f; lsum = 0.f;
        const int nch = (nvalid + 31) >> 5;
        u32x4 gv[16];
#pragma unroll
        for (int it = 0; it < 16; ++it) { const int idx = list[2 * it + (lane >> 5)]; gv[it] = *(const u32x4*)(CN + (size_t)idx * 256 + (lane & 31) * 8); }
        for (int ch = 0; ch < nch; ++ch) {
#pragma unroll
            for (int it = 0; it < 16; ++it) *(LAS u32x4*)(tile + (2 * it + (lane >> 5)) * DS_ROW + (lane & 31) * 16) = gv[it];
            if (ch + 1 < nch) {
#pragma unroll
                for (int it = 0; it < 16; ++it) { const int idx = list[(ch + 1) * 32 + 2 * it + (lane >> 5)]; gv[it] = *(const u32x4*)(CN + (size_t)idx * 256 + (lane & 31) * 8); }
            }
            f32x4 st[2];
#pragma unroll
            for (int rb = 0; rb < 2; ++rb) { st[rb] = (f32x4){0.f, 0.f, 0.f, 0.f};
#pragma unroll
                for (int s = 0; s < 8; ++s) { const bf16x8 a = *(const LAS bf16x8*)(tile + (16 * rb + hn) * DS_ROW + (32 * s + 8 * g) * 2); st[rb] = mfma16(a, bq[s], st[rb]); } }
            float mx = -1e30f;
#pragma unroll
            for (int rb = 0; rb < 2; ++rb)
#pragma unroll
                for (int i = 0; i < 4; ++i) { const int slot = ch * 32 + 16 * rb + 4 * g + i; st[rb][i] = (slot < nvalid) ? st[rb][i] : -1e30f; mx = fmaxf(mx, st[rb][i]); }
            mx = fmaxf(mx, __shfl_xor(mx, 16)); mx = fmaxf(mx, __shfl_xor(mx, 32));
            const float mnew = fmaxf(mrun, mx), alpha = __builtin_amdgcn_exp2f(mrun - mnew);
            float ps = 0.f; float p[8];
#pragma unroll
            for (int rb = 0; rb < 2; ++rb)
#pragma unroll
                for (int i = 0; i < 4; ++i) { p[4 * rb + i] = __builtin_amdgcn_exp2f(st[rb][i] - mnew); ps += p[4 * rb + i]; }
            ps += __shfl_xor(ps, 16); ps += __shfl_xor(ps, 32);
            lsum = lsum * alpha + ps; mrun = mnew;
#pragma unroll
            for (int c = 0; c < 16; ++c) O[c] *= alpha;
            u32x4 pw; pw.x = cvt_pk_bf16(p[0], p[1]); pw.y = cvt_pk_bf16(p[2], p[3]); pw.z = cvt_pk_bf16(p[4], p[5]); pw.w = cvt_pk_bf16(p[6], p[7]);
            const bf16x8 pb = as_bf16x8(pw);
            LAS unsigned char* a_lo = tile + (4 * g + (hn >> 2)) * DS_ROW + 8 * (hn & 3);
            LAS unsigned char* a_hi = a_lo + 16 * DS_ROW;
#pragma unroll
            for (int c = 0; c < 16; ++c) {
                const bf16x4 lo = __builtin_amdgcn_ds_read_tr16_b64_v4i16((LAS bf16x4*)(a_lo + 32 * c));
                const bf16x4 hi = __builtin_amdgcn_ds_read_tr16_b64_v4i16((LAS bf16x4*)(a_hi + 32 * c));
                const bf16x8 a = __builtin_shufflevector(lo, hi, 0, 1, 2, 3, 4, 5, 6, 7);
                O[c] = mfma16(a, pb, O[c]);
            }
        }
#if REP_PHASE == 222
        }
#endif
        const float inv = 1.0f / lsum;
        if (hn < 6) {
#pragma unroll
            for (int c = 0; c < 16; ++c) { u32x2 w; w.x = cvt_pk_bf16(O[c][0] * inv, O[c][1] * inv); w.y = cvt_pk_bf16(O[c][2] * inv, O[c][3] * inv);
                *(u32x2*)(OP + (size_t)t * 1536 + hn * 256 + 16 * c + 4 * g) = w; }
        }
    }
}

constexpr int RW_STRIDE = 2052;
__device__ __forceinline__ void ln_router_phase(LAS unsigned char* lds, float* X1  , const float* __restrict__ lg, const float* __restrict__ lb, const float* __restrict__ wr,
                                int* __restrict__ EID, float* __restrict__ GW, unsigned* __restrict__ ctl, int bid, int nb, int tid) {
    const int wid = tid >> 6, lane = tid & 63;
    LAS float* W = (LAS float*)lds; LAS int* tokE = (LAS int*)(lds + 16 * RW_STRIDE * 4);
    for (int idx = tid; idx < 2048 * 16; idx += NTHR) W[(idx & 15) * RW_STRIDE + (idx >> 4)] = wr[idx];
    __syncthreads();
    for (int cb = bid; cb < 256; cb += nb) {
        for (int k4 = 0; k4 < 4; ++k4) {
            const int tl = 4 * wid + k4, t = 32 * cb + tl;
            f32x4 x[8]; float s = 0.f;
#pragma unroll
            for (int k = 0; k < 8; ++k) { x[k] = *(const f32x4*)(X1 + (size_t)t * 2048 + 256 * k + 4 * lane); s += (x[k][0] + x[k][1]) + (x[k][2] + x[k][3]); }
            const float mu = wave_sum(s) * (1.0f / 2048.0f);
            float q = 0.f;
#pragma unroll
            for (int k = 0; k < 8; ++k) { const f32x4 d = x[k] - mu; q += (d[0] * d[0] + d[1] * d[1]) + (d[2] * d[2] + d[3] * d[3]); }
            const float rstd = __builtin_amdgcn_rsqf(wave_sum(q) * (1.0f / 2048.0f) + 1e-5f);
#pragma unroll
            for (int k = 0; k < 8; ++k) { const f32x4 gg = *(const f32x4*)(lg + 256 * k + 4 * lane), bb = *(const f32x4*)(lb + 256 * k + 4 * lane);
                x[k] = (x[k] - mu) * rstd * gg + bb;
                *(f32x4*)(X1 + (size_t)t * 2048 + 256 * k + 4 * lane) = x[k]; }
            float ex[16];
#pragma unroll
            for (int e = 0; e < 16; ++e) { float p = 0.f;
#pragma unroll
                for (int k = 0; k < 8; ++k) { const f32x4 w = *(const LAS f32x4*)(W + e * RW_STRIDE + 256 * k + 4 * lane); p += (x[k][0] * w[0] + x[k][1] * w[1]) + (x[k][2] * w[2] + x[k][3] * w[3]); }
                ex[e] = wave_sum(p); }
            float mx = ex[0];
#pragma unroll
            for (int e = 1; e < 16; ++e) mx = fmaxf(mx, ex[e]);
#pragma unroll
            for (int e = 0; e < 16; ++e) ex[e] = __expf(ex[e] - mx);
            float gs[4];
#pragma unroll
            for (int g = 0; g < 4; ++g) { const float a = ex[4 * g], b = ex[4 * g + 1], c = ex[4 * g + 2], d = ex[4 * g + 3];
                const float h1 = fmaxf(a, b), l1 = fminf(a, b), h2 = fmaxf(c, d), l2 = fminf(c, d);
                gs[g] = fmaxf(h1, h2) + fmaxf(fminf(h1, h2), fmaxf(l1, l2)); }
            int gsel = 0; float gbest = gs[0];
#pragma unroll
            for (int g = 1; g < 4; ++g) if (gs[g] > gbest) { gbest = gs[g]; gsel = g; }
            float v[4];
#pragma unroll
            for (int j = 0; j < 4; ++j) v[j] = gsel == 0 ? ex[j] : (gsel == 1 ? ex[4 + j] : (gsel == 2 ? ex[8 + j] : ex[12 + j]));
            int i0 = 0; float v0 = v[0];
#pragma unroll
            for (int j = 1; j < 4; ++j) if (v[j] > v0) { v0 = v[j]; i0 = j; }
            int i1 = (i0 + 1) & 3; float v1 = -1.f;
#pragma unroll
            for (int j = 0; j < 4; ++j) if (j != i0 && v[j] > v1) { v1 = v[j]; i1 = j; }
            const float inv = 1.0f / (v0 + v1);
            if (lane == 0) { const int e0 = 4 * gsel + i0, e1 = 4 * gsel + i1; tokE[2 * tl] = e0; tokE[2 * tl + 1] = e1;
                EID[2 * t] = e0; EID[2 * t + 1] = e1; GW[2 * t] = v0 * inv; GW[2 * t + 1] = v1 * inv; }
        }
        __syncthreads();
        if (tid < 16) { int c = 0; for (int i = 0; i < 64; ++i) c += (tokE[i] == tid) ? 1 : 0; ctl[CW_BCNT + cb * 16 + tid] = (unsigned)c; }
        __syncthreads();
    }
}
__device__ __forceinline__ void dispatch_phase(LAS unsigned char* lds, const float* __restrict__ X1, const int* __restrict__ EID, const float* __restrict__ GW, int* __restrict__ SLOT, float* __restrict__ SGW,
                               bf16_t* __restrict__ XS, unsigned* __restrict__ ctl, int bid, int nb, int tid) {
    LAS int* tot = (LAS int*)lds; LAS int* pre = tot + 16; LAS int* off = tot + 32; LAS int* slot = tot + 64; LAS int* eidl = tot + 128;
    for (int cb = bid; cb < 256; cb += nb) {
        if (tid < 32) { tot[tid] = 0; }
        __syncthreads();
        {
            const int e = tid & 15, part = tid >> 4; int tt = 0, pp = 0;
#pragma unroll
            for (int k = 0; k < 8; ++k) { const int b = part * 8 + k; const int c = (int)ctl[CW_BCNT + b * 16 + e]; tt += c; pp += (b < cb) ? c : 0; }
            __hip_atomic_fetch_add(tot + e, tt, __ATOMIC_RELAXED, __HIP_MEMORY_SCOPE_WORKGROUP); __hip_atomic_fetch_add(pre + e, pp, __ATOMIC_RELAXED, __HIP_MEMORY_SCOPE_WORKGROUP); }
        __syncthreads();
        if (tid == 0) { int base = 0;
            for (int e = 0; e < 16; ++e) { off[e] = base + pre[e]; const int nt = (tot[e] + 255) >> 8;
                if (cb == 0) for (int k = 0; k < nt; ++k) ctl[CW_TEXP + (base >> 8) + k] = (unsigned)e;
                base += nt << 8; }
            if (cb == 0) ctl[CW_NT] = (unsigned)(base >> 8); }
        __syncthreads();
        if (tid < 64) slot[tid] = XS_ROWS - 1;
        __syncthreads();
        if (tid < 64) eidl[tid] = EID[64 * cb + tid];
        __syncthreads();
        if (tid < 64) { const int e = eidl[tid]; int r = 0; for (int i = 0; i < 64; ++i) r += (i < tid && eidl[i] == e) ? 1 : 0; if (e >= 0 && e < 16) slot[tid] = off[e] + r; }
        __syncthreads();
        if (tid < 64) { const int sl = slot[tid]; SLOT[64 * cb + tid] = sl; SGW[sl] = GW[64 * cb + tid]; }
        for (int pr = 0; pr < 64; ++pr) { const int t = 32 * cb + (pr >> 1), sl = slot[pr];
            const f32x4 v = *(const f32x4*)(X1 + (size_t)t * 2048 + tid * 4);
            u32x2 w; w.x = cvt_pk_bf16(v[0], v[1]); w.y = cvt_pk_bf16(v[2], v[3]); *(u32x2*)(XS + (size_t)sl * 2048 + tid * 4) = w; }
        __syncthreads();
    }
}
__device__ __forceinline__ void combine_ln2_phase(const float* __restrict__ X1, const bf16_t* __restrict__ DN, const int* __restrict__ SLOT, const float* __restrict__ lg, const float* __restrict__ lb,
                                  float* __restrict__ outF, bf16_t* __restrict__ outB, int bid, int nb, int tid) {
    const int wid = tid >> 6, lane = tid & 63;
    for (int t = bid * 8 + wid; t < SEQ; t += nb * 8) {
        const int s0 = SLOT[2 * t], s1 = SLOT[2 * t + 1];
        f32x4 x[8]; float s = 0.f;
#pragma unroll
        for (int k = 0; k < 8; ++k) { const f32x4 a = *(const f32x4*)(X1 + (size_t)t * 2048 + 256 * k + 4 * lane);
            const u32x2 d0 = *(const u32x2*)(DN + (size_t)s0 * 2048 + 256 * k + 4 * lane), d1 = *(const u32x2*)(DN + (size_t)s1 * 2048 + 256 * k + 4 * lane);
            x[k][0] = a[0] * ALPHA + (bflo(d0.x) + bflo(d1.x)); x[k][1] = a[1] * ALPHA + (bfhi(d0.x) + bfhi(d1.x));
            x[k][2] = a[2] * ALPHA + (bflo(d0.y) + bflo(d1.y)); x[k][3] = a[3] * ALPHA + (bfhi(d0.y) + bfhi(d1.y));
            s += (x[k][0] + x[k][1]) + (x[k][2] + x[k][3]); }
        const float mu = wave_sum(s) * (1.0f / 2048.0f);
        float q = 0.f;
#pragma unroll
        for (int k = 0; k < 8; ++k) { const f32x4 d = x[k] - mu; q += (d[0] * d[0] + d[1] * d[1]) + (d[2] * d[2] + d[3] * d[3]); }
        const float rstd = __builtin_amdgcn_rsqf(wave_sum(q) * (1.0f / 2048.0f) + 1e-5f);
#pragma unroll
        for (int k = 0; k < 8; ++k) { const f32x4 gg = *(const f32x4*)(lg + 256 * k + 4 * lane), bb = *(const f32x4*)(lb + 256 * k + 4 * lane);
            const f32x4 y = (x[k] - mu) * rstd * gg + bb;
            *(f32x4*)(outF + (size_t)t * 2048 + 256 * k + 4 * lane) = y;
            if (outB) { u32x2 w; w.x = cvt_pk_bf16(y[0], y[1]); w.y = cvt_pk_bf16(y[2], y[3]); *(u32x2*)(outB + (size_t)t * 2048 + 256 * k + 4 * lane) = w; } }
    }
}

#define IN(k) (P.ph_lo <= (k) && (k) < P.ph_hi)
#define SEAM(k) do { if (IN(k) && IN((k) + 1)) xcd_barrier(bar, wid0); } while (0)
#define LAUNDER() int tid = wid0 * 64 + (int)__builtin_amdgcn_mbcnt_hi(~0u, __builtin_amdgcn_mbcnt_lo(~0u, 0u)), bid = bid0; unsigned char* ws = P.ws; asm volatile("" : "+v"(tid)); asm volatile("" : "+s"(bid)); asm volatile("" : "+s"(ws)); unsigned* ctl = (unsigned*)(ws + WS_CTL);
#ifndef REP_PHASE
#define REP_PHASE -1
#endif
#define REPK(k) for (int rep_ = 0; rep_ < ((REP_PHASE == (k)) ? 2 : 1); ++rep_)
#define REPSYNC(k) do { if (REP_PHASE == (k)) __syncthreads(); } while (0)
template <int l> __device__ __forceinline__ void layer_phases(const Params& P, LAS unsigned char* lds, const XcdBarrier& bar, const int wid0, const int bid0, const int nb) {
        constexpr int pb = 1 + 10 * l;
        if (IN(pb + 0)) REPK(0) {
            LAUNDER()
            ProjSched S{(const char*)(ws + WS_Z), nb, bid}; ProjEpi E{ws};
            pg8::gemm_phase(lds, pg8::Dims{2048, 2048, 2048}, S, E, tid);
            REPSYNC(0);
        } SEAM(pb + 0);
        if (IN(pb + 1)) {
            LAUNDER()
            REPK(11) sb_attn_phase(lds, (const bf16_t*)(ws + WS_QSB), (const bf16_t*)(ws + WS_KSB), (const bf16_t*)(ws + WS_VT), (bf16_t*)(ws + WS_YCAT), 0, bid, nb, tid);
            REPK(12) ret_kv_phase(lds, (const bf16_t*)(ws + WS_KR), (const bf16_t*)(ws + WS_VR), (const f32x2*)(ws + WS_ROT), (float*)(ws + WS_KVT), 192, bid, nb, tid);
            cn_phase((const bf16_t*)(ws + WS_CKV), P.kv_norm_g + l * 256, (bf16_t*)(ws + WS_CN), bid, nb, tid);
            REPK(13) { GridSched S{(const char*)(ws + WS_QD), (const char*)(ws + WS_WABS), 32, 2, 3, (size_t)256 * 768 * 2, (size_t)256 * 256 * 2, (size_t)256 * 2, (size_t)512 * 256 * 2, nb, (bid + 64) % nb};
              Bf16Epi E{(bf16_t*)(ws + WS_QP), 1536, 512, SB_QSCALE};
              pg8::gemm_phase(lds, pg8::Dims{256, 768, 256}, S, E, tid); }
            REPK(14) score_phase((const bf16_t*)(ws + WS_QI), (const bf16_t*)(ws + WS_KW), (float*)(ws + WS_SC), 0, bid, nb, tid);
        } SEAM(pb + 1);
        if (IN(pb + 2)) REPK(2) {
            LAUNDER()
            ret_scan_phase((const float*)(ws + WS_KVT), (bf16_t*)(ws + WS_ST), bid, nb, tid);
            REPK(22) dsa_phase(lds, (const float*)(ws + WS_SC), (const bf16_t*)(ws + WS_CN), (const bf16_t*)(ws + WS_QP), (bf16_t*)(ws + WS_OP), bid, nb, tid);
            REPSYNC(2);
        } SEAM(pb + 2);
        if (IN(pb + 3)) REPK(3) {
            LAUNDER()
            ret_out_phase(lds, (const bf16_t*)(ws + WS_QR), (const bf16_t*)(ws + WS_KR), (const bf16_t*)(ws + WS_VR), (const bf16_t*)(ws + WS_GR), (const f32x2*)(ws + WS_ROT),
                          (const bf16_t*)(ws + WS_ST), P.ret_gn_g + l * 512, (bf16_t*)(ws + WS_YCAT), 0, bid, nb, tid);
            { GridSched S{(const char*)(ws + WS_OP), (const char*)(ws + WS_WUVP), 32, 1, 3, (size_t)256 * 1536 * 2, (size_t)256 * 512 * 2, (size_t)512 * 2, (size_t)256 * 512 * 2, nb, bid};
              Bf16Epi E{(bf16_t*)(ws + WS_YCAT) + 1280, 2048, 256, 1.0f};
              pg8::gemm_phase(lds, pg8::Dims{512, 1536, 512}, S, E, tid); }
            REPSYNC(3);
        } SEAM(pb + 3);
        if (IN(pb + 4)) REPK(4) {
            LAUNDER()
            GridSched S{(const char*)(ws + WS_YCAT), (const char*)(ws + WS_WOT), 32, 8, 1, TS2048, TS2048, 0, 0, nb, bid};
            ResF32Epi E{(float*)(ws + WS_X1), l ? (const float*)P.out : P.x};
            pg8::gemm_phase(lds, pg8::Dims{2048, 2048, 2048}, S, E, tid);
            REPSYNC(4);
        } SEAM(pb + 4);
        if (IN(pb + 5)) {
            LAUNDER()
            ln_router_phase(lds, (float*)(ws + WS_X1), P.ln1_g + l * 2048, P.ln1_b + l * 2048, P.w_router, (int*)(ws + WS_EID), (float*)(ws + WS_GW), ctl, bid, nb, tid);
        } SEAM(pb + 5);
        if (IN(pb + 6)) REPK(6) {
            LAUNDER()
            dispatch_phase(lds, (const float*)(ws + WS_X1), (const int*)(ws + WS_EID), (const float*)(ws + WS_GW), (int*)(ws + WS_SLOT), (float*)(ws + WS_SGW), (bf16_t*)(ws + WS_XS), ctl, bid, nb, tid);
            REPSYNC(6);
        } SEAM(pb + 6);
        if (IN(pb + 7)) REPK(7) {
            LAUNDER()
            MoeSched S{(const char*)(ws + WS_XS), (const char*)(ws + WS_WGU), ctl, 4, TS2048, TS2048, nb, bid};
            GateUpEpi E{(bf16_t*)(ws + WS_ACT), (const float*)(ws + WS_SGW)};
            pg8::gemm_phase(lds, pg8::Dims{2048, 2048, 2048}, S, E, tid);
            REPSYNC(7);
        } SEAM(pb + 7);
        if (IN(pb + 8)) REPK(8) {
            LAUNDER()
            MoeSched S{(const char*)(ws + WS_ACT), (const char*)(ws + WS_WDT), ctl, 8, (size_t)256 * 512 * 2, (size_t)256 * 512 * 2, nb, bid};
            DownEpi E{(bf16_t*)(ws + WS_DN)};
            pg8::gemm_phase(lds, pg8::Dims{512, 512, 512}, S, E, tid);
            REPSYNC(8);
        } SEAM(pb + 8);
        if (IN(pb + 9)) REPK(9) {
            LAUNDER()
            combine_ln2_phase((const float*)(ws + WS_X1), (const bf16_t*)(ws + WS_DN), (const int*)(ws + WS_SLOT), P.ln2_g + l * 2048, P.ln2_b + l * 2048,
                              P.out, l ? (bf16_t*)nullptr : (bf16_t*)(ws + WS_Z), bid, nb, tid);
            if (l == 0) p0_weights(P, ws, lds, 1, bid, nb, tid);
            REPSYNC(9);
        } SEAM(pb + 9);
}
constexpr int NPHASE = 21;
__global__ void __launch_bounds__(NTHR, 2) fwd_kernel(Params P) {
    extern __shared__ __attribute__((aligned(16))) unsigned char smem[];
    LAS unsigned char* lds = (LAS unsigned char*)smem;
    const int tid0 = threadIdx.x, bid0 = blockIdx.x, nb = gridDim.x; const int wid0 = __builtin_amdgcn_readfirstlane(tid0 >> 6);
    unsigned* ctl0 = (unsigned*)(P.ws + WS_CTL);
    volatile LAS unsigned* bst = (volatile LAS unsigned*)(lds + LDS_BYTES - 16);
    const bool multi = (P.ph_hi - P.ph_lo) > 1;
    if (tid0 == 0) { bst[0] = 0u; bst[1] = 0u; bst[2] = 0u; bst[3] = 0u; }
    __syncthreads();
    XcdBarrier bar; bar.bar = ctl0 + CW_BAR; bar.x = 0; bar.st = bst;
    if (multi) bar = xcd_barrier_post(ctl0 + CW_BAR, bst);
    if (IN(0)) REPK(100) { LAUNDER() (void)ctl; p0_common(P, ws, bid, nb, tid); p0_weights(P, ws, lds, 0, bid, nb, tid); } SEAM(0);
    layer_phases<0>(P, lds, bar, wid0, bid0, nb);
    layer_phases<1>(P, lds, bar, wid0, bid0, nb);
#undef IN
#undef SEAM
}

#ifndef N_LAUNCHES
#define N_LAUNCHES 1
#endif
extern "C" void kernel_launch(void* const* d_in, const int* in_sizes, int n_in, void* d_out, int out_size, void* d_ws, size_t ws_size, hipStream_t stream) {
    static int grid = 0;
    if (grid == 0) {
        int dev = 0, cus = 0, per_cu = 0;
        if (n_in != 14 || ws_size < WS_END) { fprintf(stderr, "kernel_launch: bad arguments (n_in %d, ws %zu < %zu)\n", n_in, ws_size, (size_t)WS_END); grid = -1; return; }
        if (hipGetDevice(&dev) != hipSuccess || hipDeviceGetAttribute(&cus, hipDeviceAttributeMultiprocessorCount, dev) != hipSuccess) { grid = -1; return; }
        if (hipFuncSetAttribute((const void*)fwd_kernel, hipFuncAttributeMaxDynamicSharedMemorySize, LDS_BYTES) != hipSuccess) { fprintf(stderr, "kernel_launch: hipFuncSetAttribute failed\n"); grid = -1; return; }
        if (hipOccupancyMaxActiveBlocksPerMultiprocessor(&per_cu, (const void*)fwd_kernel, NTHR, LDS_BYTES) != hipSuccess || per_cu < 1) fprintf(stderr, "kernel_launch: occupancy query says %d\n", per_cu);
        (void)hipGetLastError();
        grid = cus;
    }
    if (grid < 0) return;
    (void)hipMemsetAsync((char*)d_ws + WS_CTL, 0, CTL_BYTES, stream);
    Params p{};
    p.x = (const float*)d_in[0]; p.w_in = (const float*)d_in[1]; p.w_kv_up = (const float*)d_in[2]; p.kv_norm_g = (const float*)d_in[3]; p.ret_gn_g = (const float*)d_in[4];
    p.w_o = (const float*)d_in[5]; p.ln1_g = (const float*)d_in[6]; p.ln1_b = (const float*)d_in[7]; p.w_router = (const float*)d_in[8];
    p.w_gate = (const float*)d_in[9]; p.w_up = (const float*)d_in[10]; p.w_down = (const float*)d_in[11]; p.ln2_g = (const float*)d_in[12]; p.ln2_b = (const float*)d_in[13];
    p.out = (float*)d_out; p.ws = (unsigned char*)d_ws;
    if (N_LAUNCHES == 1) { p.ph_lo = 0; p.ph_hi = NPHASE; hipLaunchKernelGGL(fwd_kernel, dim3(grid), dim3(NTHR), LDS_BYTES, stream, p); }
    else for (int k = 0; k < NPHASE; ++k) { p.ph_lo = k; p.ph_hi = k + 1; hipLaunchKernelGGL(fwd_kernel, dim3(grid), dim3(NTHR), LDS_BYTES, stream, p); }
}
```
